# Optimizing an MI355X kernel written in HIP

```python
import jax, jax.numpy as jnp
from jax import lax
import numpy as np

D_MODEL = 1024
BATCH = 32
SEQ = 2048
DEPTH = 1

CTX_LEN = 256
GRID_W = 64
N_MOD = 6
EPS = 1e-6
A_HEADS = 8
A_HEAD_DIM = 128
A_WIDTH = A_HEADS * A_HEAD_DIM
A_CHUNK = 64
B_GROUPS = 8
B_GROUP_DIM = 128
B_WIDTH = B_GROUPS * B_GROUP_DIM
B_CHUNK = 128
B_ROWS_PER_CHUNK = B_CHUNK // GRID_W
N_EXPERTS = 32
TOP_K = 4
D_EXPERT = 1024
SWIGLU_LIMIT = 7.0
SWIGLU_ALPHA = 1.702
MOE_BLOCK = 256
SPLITS = (A_WIDTH, A_WIDTH, A_WIDTH, A_WIDTH, A_WIDTH, B_WIDTH, B_WIDTH, D_MODEL, D_MODEL)
IN_WIDTH = 5 * A_WIDTH + 2 * B_WIDTH + 2 * D_MODEL

kernel_name = "hybrid_hgrn2_chunkmlp_moe_dit_block"


def rms_norm(x, g):
    xf = x.astype(jnp.float32)
    y = xf * lax.rsqrt(jnp.mean(xf * xf, axis=-1, keepdims=True) + EPS)
    return (y * g).astype(x.dtype)


def modulate(x, g, shift, scale):
    return rms_norm(x, g) * (1.0 + scale) + shift


def project(h, w_in, lb_f, lb_b):
    bsz, t, _ = h.shape
    z = h @ w_in
    q, i, f_fwd, f_bwd, og, u, v, gate_a, gate_b = jnp.split(
        z, np.cumsum(SPLITS)[:-1].tolist(), axis=-1)

    def heads(a):
        return a.astype(jnp.float32).reshape(bsz, t, A_HEADS, A_HEAD_DIM)

    def decay(f_logit, lb):
        f = lb + (1.0 - lb) * jax.nn.sigmoid(f_logit.astype(jnp.float32))
        return heads(1.0 - f), heads(jnp.log(f))

    k_f, logf_f = decay(f_fwd, lb_f)
    k_b, logf_b = decay(f_bwd, lb_b)
    return (heads(jax.nn.silu(q)), heads(i), k_f, logf_f, k_b, logf_b, og,
            jax.nn.gelu(u, approximate=False), jax.nn.gelu(v, approximate=False),
            gate_a, gate_b)


def gla_chunked(q, k, v, logf, s0):
    bsz, t, nh, dk = q.shape
    dv = v.shape[-1]
    n = t // A_CHUNK

    def to_chunks(a):
        return jnp.swapaxes(a.reshape(bsz, n, A_CHUNK, nh, a.shape[-1]), 0, 1)

    lower = jnp.tril(jnp.ones((A_CHUNK, A_CHUNK), dtype=bool))

    def step(s, xs):
        qc, kc, vc, gc = xs
        b = jnp.cumsum(gc, axis=1)
        b_ref = b[:, A_CHUNK // 2 - 1:A_CHUNK // 2]
        b_end = b[:, -1]
        scores = jnp.einsum('bthd,bshd->bhts', qc * jnp.exp(b - b_ref), kc * jnp.exp(b_ref - b))
        scores = jnp.where(lower, scores, 0.0)
        o = (jnp.einsum('bhts,bshv->bthv', scores, vc)
             + jnp.einsum('bthd,bhdv->bthv', qc * jnp.exp(b), s))
        s = (jnp.exp(b_end)[..., None] * s
             + jnp.einsum('bshd,bshv->bhdv', kc * jnp.exp(b_end[:, None] - b), vc))
        return s, o

    _, o = lax.scan(step, s0, (to_chunks(q), to_chunks(k), to_chunks(v), to_chunks(logf)))
    return jnp.swapaxes(o, 0, 1).reshape(bsz, t, nh, dv)


def final_state(k, v, logf):
    tail = lax.cumsum(logf, axis=1, reverse=True) - logf
    return jnp.einsum('bshd,bshv->bhdv', k * jnp.exp(tail), v)


def context_states(p):
    q, i, k_f, logf_f, k_b, logf_b = p[:6]
    rev = lambda a: jnp.flip(a, axis=1)
    return final_state(k_f, i, logf_f), final_state(rev(k_b), rev(i), rev(logf_b))


def chunk_mlp(u, v, w_s, b_s, n_chunks):
    bsz, t, _ = v.shape
    vf = v.astype(jnp.float32)
    mu = jnp.mean(vf, axis=-1, keepdims=True)
    var = jnp.mean(jnp.square(vf - mu), axis=-1, keepdims=True)
    vn = ((vf - mu) * lax.rsqrt(var + EPS)).astype(v.dtype)
    vn = vn.reshape(bsz, n_chunks, B_CHUNK, B_GROUPS, B_GROUP_DIM)
    s = jnp.einsum('gtp,bnpgc->bntgc', w_s, vn) + b_s.T[:, :, None]
    return u * s.reshape(bsz, t, B_WIDTH)


def token_mix(p, s_fwd0, s_bwd0, gnorm_g, w_s, b_s, w_branch_a, w_branch_b, w_out, n_chunks):
    q, i, k_f, logf_f, k_b, logf_b, og, u, v, gate_a, gate_b = p
    bsz, t = og.shape[:2]
    rev = lambda a: jnp.flip(a, axis=1)
    o = (gla_chunked(q, k_f, i, logf_f, s_fwd0)
         + rev(gla_chunked(rev(q), rev(k_b), rev(i), rev(logf_b), s_bwd0)))
    y_a = rms_norm(o, gnorm_g).reshape(bsz, t, A_WIDTH).astype(og.dtype) * jax.nn.silu(og)
    y_b = chunk_mlp(u, v, w_s, b_s, n_chunks)
    merged = (jax.nn.sigmoid(gate_a) * (y_a @ w_branch_a)
              + jax.nn.sigmoid(gate_b) * (y_b @ w_branch_b))
    return merged @ w_out


def moe_ffn(h, w_router, b_router, w1, b1, w2, b2):
    bsz, t, d = h.shape
    hf = h.reshape(bsz * t, d)
    n_tok = hf.shape[0]
    n_assign = n_tok * TOP_K
    logits = (hf @ w_router + b_router).astype(jnp.float32)
    top_logit, top_e = lax.top_k(logits, TOP_K)
    top_w = jax.nn.softmax(top_logit, axis=-1)
    e_flat = top_e.reshape(-1).astype(jnp.int32)
    w_flat = top_w.reshape(-1)
    e_sorted, order = lax.sort((e_flat, jnp.arange(n_assign, dtype=jnp.int32)),
                               num_keys=1, is_stable=True)
    counts = jnp.bincount(e_flat, length=N_EXPERTS)
    starts = jnp.cumsum(counts) - counts
    padded = (counts + MOE_BLOCK - 1) // MOE_BLOCK * MOE_BLOCK
    pad_ends = jnp.cumsum(padded)
    pad_starts = pad_ends - padded
    dest = pad_starts[e_sorted] + (jnp.arange(n_assign, dtype=jnp.int32) - starts[e_sorted])
    n_blocks = -(-n_assign // MOE_BLOCK) + N_EXPERTS
    cap = n_blocks * MOE_BLOCK
    slot_tok = jnp.full((cap,), n_tok, jnp.int32).at[dest].set(order // TOP_K)
    slot_w = jnp.zeros((cap,), jnp.float32).at[dest].set(w_flat[order])
    block_e = jnp.clip(jnp.searchsorted(pad_ends, jnp.arange(n_blocks) * MOE_BLOCK, side='right'),
                       0, N_EXPERTS - 1)
    x_pad = jnp.concatenate([hf, jnp.zeros((1, d), hf.dtype)], axis=0)
    xb = x_pad[slot_tok].reshape(n_blocks, MOE_BLOCK, d)

    def expert_block(args):
        xblk, e = args
        z = xblk @ w1[e] + b1[e]
        gate = jnp.minimum(z[:, :D_EXPERT], SWIGLU_LIMIT)
        lin = jnp.clip(z[:, D_EXPERT:], -SWIGLU_LIMIT, SWIGLU_LIMIT)
        return (gate * jax.nn.sigmoid(SWIGLU_ALPHA * gate) * (lin + 1.0)) @ w2[e] + b2[e]

    y = lax.map(expert_block, (xb, block_e)).reshape(cap, d)
    out = jnp.zeros((n_tok + 1, d), hf.dtype).at[slot_tok].add(
        (y * slot_w[:, None]).astype(hf.dtype))[:n_tok]
    return out.reshape(bsz, t, d)


def setup_inputs(seed: int = 0) -> dict:
    key = jax.random.key(seed)
    ks = jax.random.split(key, 24)
    nrm = lambda k, shape, s: s * jax.random.normal(k, shape, jnp.float32)
    L, E, F = DEPTH, N_EXPERTS, D_EXPERT
    return {
        'x': nrm(ks[0], (BATCH, SEQ, D_MODEL), 1.0),
        'c': nrm(ks[1], (BATCH, D_MODEL), 1.0),
        'ctx': nrm(ks[2], (BATCH, CTX_LEN, D_MODEL), 1.0),
        'c_ctx': nrm(ks[3], (D_MODEL,), 1.0),
        'norm1_g': 1.0 + nrm(ks[4], (L, D_MODEL), 0.02),
        'norm2_g': 1.0 + nrm(ks[5], (L, D_MODEL), 0.02),
        'w_mod': nrm(ks[6], (L, D_MODEL, N_MOD * D_MODEL), 0.5 * D_MODEL ** -0.5),
        'b_mod': nrm(ks[7], (L, N_MOD * D_MODEL), 0.02),
        'w_in': nrm(ks[8], (L, D_MODEL, IN_WIDTH), D_MODEL ** -0.5),
        'lb_fwd': nrm(ks[9], (L + 1, A_WIDTH), 0.1),
        'lb_bwd': nrm(ks[10], (L + 1, A_WIDTH), 0.1),
        'gnorm_g': 1.0 + nrm(ks[11], (L, A_HEAD_DIM), 0.02),
        'w_s': nrm(ks[12], (L, B_GROUPS, B_CHUNK, B_CHUNK), B_CHUNK ** -0.5),
        'b_s': nrm(ks[13], (L, B_GROUPS, B_CHUNK), 0.02),
        'w_branch_a': nrm(ks[14], (L, A_WIDTH, D_MODEL), A_WIDTH ** -0.5),
        'w_branch_b': nrm(ks[15], (L, B_WIDTH, D_MODEL), B_WIDTH ** -0.5),
        'w_out': nrm(ks[16], (L, D_MODEL, D_MODEL), D_MODEL ** -0.5),
        'w_router': nrm(ks[17], (L, D_MODEL, E), D_MODEL ** -0.5),
        'b_router': nrm(ks[18], (L, E), 0.01),
        'w1': nrm(ks[19], (L, E, D_MODEL, 2 * F), D_MODEL ** -0.5),
        'b1': nrm(ks[20], (L, E, 2 * F), 0.02),
        'w2': nrm(ks[21], (L, E, F, D_MODEL), F ** -0.5),
        'b2': nrm(ks[22], (L, E, D_MODEL), 0.02),
        'final_g': 1.0 + nrm(ks[23], (D_MODEL,), 0.02),
    }


def reference(x, c, ctx, c_ctx, norm1_g, norm2_g, w_mod, b_mod, w_in, lb_fwd, lb_bwd, gnorm_g,
              w_s, b_s, w_branch_a, w_branch_b, w_out, w_router, b_router, w1, b1, w2, b2, final_g):
    bsz, t, d = x.shape
    rows = t // GRID_W
    lat_chunks = rows // B_ROWS_PER_CHUNK
    ctx_chunks = ctx.shape[1] // B_CHUNK
    lb_f_all = jnp.cumsum(jax.nn.softmax(lb_fwd.astype(jnp.float32), axis=0), axis=0)
    lb_b_all = jnp.cumsum(jax.nn.softmax(lb_bwd.astype(jnp.float32), axis=0), axis=0)
    for layer in range(DEPTH):
        last = layer == DEPTH - 1
        mod = jax.nn.silu(c) @ w_mod[layer] + b_mod[layer]
        mod_c = jax.nn.silu(c_ctx) @ w_mod[layer] + b_mod[layer]
        sh1, sc1, g1, sh2, sc2, g2 = jnp.split(mod[:, None, :], N_MOD, axis=-1)
        csh1, csc1, cg1, csh2, csc2, cg2 = jnp.split(mod_c, N_MOD)
        p_lat = project(modulate(x, norm1_g[layer], sh1, sc1), w_in[layer],
                        lb_f_all[layer], lb_b_all[layer])
        p_ctx = project(modulate(ctx, norm1_g[layer], csh1, csc1), w_in[layer],
                        lb_f_all[layer], lb_b_all[layer])
        s_fwd, s_bwd = context_states(p_ctx)
        mix_w = (gnorm_g[layer], w_s[layer], b_s[layer], w_branch_a[layer], w_branch_b[layer],
                 w_out[layer])
        ffn_w = (w_router[layer], b_router[layer], w1[layer], b1[layer], w2[layer], b2[layer])
        x = x + g1 * token_mix(p_lat, s_fwd, s_bwd, *mix_w, lat_chunks)
        x = x + g2 * moe_ffn(modulate(x, norm2_g[layer], sh2, sc2), *ffn_w)
        if not last:
            zero = jnp.zeros_like(s_fwd)
            ctx = ctx + cg1 * token_mix(p_ctx, zero, zero, *mix_w, ctx_chunks)
            ctx = ctx + cg2 * moe_ffn(modulate(ctx, norm2_g[layer], csh2, csc2), *ffn_w)
    return rms_norm(x, final_g)
```

```cpp
#include <hip/hip_runtime.h>
#include <cstdio>
#include <cstdint>

#ifndef MK_P0_TAIL_PCT
#define MK_P0_TAIL_PCT 18
#endif
#ifndef MK_PER_PHASE
#define MK_PER_PHASE 0
#endif
#ifndef MK_SKIP_MIXER
#define MK_SKIP_MIXER 0
#endif
#ifndef MK_NO_A
#define MK_NO_A 0
#endif
#ifndef MK_NO_B
#define MK_NO_B 0
#endif
#ifndef MK_GLA_MODE
#define MK_GLA_MODE 0
#endif
#ifndef MK_REP_PHASE
#define MK_REP_PHASE -1
#endif
#define REPS(k) ((MK_REP_PHASE == (k)) ? 2 : 1)
#ifndef MK_P2_FP8
#define MK_P2_FP8 1
#endif
#ifndef MK_TIME_PHASE
#define MK_TIME_PHASE -1
#endif
#ifndef MK_P6_FP8
#define MK_P6_FP8 1
#endif
#ifndef MK_P5_FP8
#define MK_P5_FP8 1
#endif
#ifndef MK_SKIP_MOE
#define MK_SKIP_MOE 0
#endif

#define GAS __attribute__((address_space(1)))
#define LAS __attribute__((address_space(3)))
typedef unsigned short bf16;
typedef short bf16x8 __attribute__((ext_vector_type(8)));
typedef float f32x4 __attribute__((ext_vector_type(4)));
typedef float f32x2 __attribute__((ext_vector_type(2)));
typedef unsigned u32x4 __attribute__((ext_vector_type(4)));
typedef unsigned u32x2 __attribute__((ext_vector_type(2)));
typedef GAS unsigned gu32;

constexpr int D = 1024, NB = 32, T = 2048, CTXL = 256, NTOK = NB * T, NCTX = NB * CTXL;
constexpr int GB = 16, NG = NB / GB, TG = GB * T;
constexpr int INW = 9216, NE = 32, FE = 1024, TOPK = 4;
constexpr float EPS = 1e-6f;
constexpr int NPH = 10;
constexpr int NPID = 1 + NG * NPH;

constexpr size_t MiB = 1u << 20;
constexpr size_t WS_CTL = 0, CTL_ZERO_BYTES = 128 * 1024;
constexpr size_t WS_MOD = 1 * MiB;
constexpr size_t WS_LB = WS_MOD + 33 * 6144 * 4;
constexpr size_t WS_WRT = WS_LB + 2 * 1024 * 4;
constexpr size_t WS_WSB = 2 * MiB;
constexpr size_t WS_TOPW = 3 * MiB;
constexpr size_t WS_SPOS = 3 * MiB + 512 * 1024;
constexpr size_t WS_VSTAT = 4 * MiB;
constexpr size_t WS_LIST = 8 * MiB;
constexpr size_t WS_WIN = 12 * MiB;
constexpr size_t WS_WBA = 22 * MiB, WS_WBB = 23 * MiB, WS_WOUT = 24 * MiB;
constexpr size_t WS_W1 = 25 * MiB;
constexpr size_t WS_W2 = 89 * MiB;
constexpr size_t WS_H = 121 * MiB;
constexpr size_t WS_HC = 153 * MiB;
constexpr size_t WS_ZC = 161 * MiB;
constexpr size_t WS_Z = 209 * MiB;
constexpr size_t WS_ACT = WS_Z;
constexpr size_t WS_YSLOT = WS_Z + 136 * MiB;
constexpr size_t WS_YA = 785 * MiB, WS_YB = 817 * MiB;
constexpr size_t WS_MERGED = 849 * MiB;
constexpr size_t WS_T = 881 * MiB;
constexpr size_t WS_END = 945 * MiB;
constexpr size_t OUT_SCR = (size_t)TG * D * 4;
constexpr size_t OS_OF = 0, OS_OB = 64 * MiB;
constexpr size_t OS_TB = 0;
static_assert(NG == 2 && MK_P2_FP8 && MK_P5_FP8 && MK_P6_FP8, "this workspace map is sized for two groups and e4m3 operands");
static_assert(WS_WRT + 32 * 1024 * 4 <= WS_WSB && WS_YSLOT + ((size_t)TG * 4 + 32 * 256) * 1024 * 2 <= WS_Z + 576 * MiB && WS_ACT + ((size_t)TG * 4 + 32 * 256) * 1024 <= WS_YSLOT, "ws map");
static_assert(OS_OB + (size_t)TG * D * 2 <= (size_t)TG * D * 4, "d_out scratch");
constexpr int CW_BAR = 4096;
constexpr int CW_CNT = 16384;

constexpr int RING_BYTES = 131072;
constexpr int LDS_BYTES = 147456;
constexpr int LDSCTL_OFF = 146432;
constexpr int LC_BAR = 0;
constexpr int LC_PT = 8;
constexpr int LC_CNT = 48;
constexpr int LC_LCNT = 80;
constexpr int LC_LBASE = 112;
constexpr int EXPT_BYTES_OFF = 141312;
constexpr int LC_EXPT = (EXPT_BYTES_OFF - LDSCTL_OFF) / 4;
static_assert(LDSCTL_OFF + 1024 == LDS_BYTES, "lds map");

__device__ __forceinline__ float bflo(unsigned w) { return __uint_as_float(w << 16); }
__device__ __forceinline__ float bfhi(unsigned w) { return __uint_as_float(w & 0xffff0000u); }
__device__ __forceinline__ float bf2f(bf16 b) { return __uint_as_float(((unsigned)b) << 16); }
typedef __bf16 bf16v2 __attribute__((ext_vector_type(2)));
__device__ __forceinline__ unsigned cvt_pk_bf16(float lo, float hi) { const f32x2 v = (f32x2){lo, hi}; const bf16v2 r = __builtin_convertvector(v, bf16v2); return __builtin_bit_cast(unsigned, r); }
typedef int i32x8 __attribute__((ext_vector_type(8)));
typedef int i32x4 __attribute__((ext_vector_type(4)));
__device__ __forceinline__ unsigned pack4_fp8(float a, float b, float c, float d) {
    a = __builtin_fminf(__builtin_fmaxf(a, -448.f), 448.f); b = __builtin_fminf(__builtin_fmaxf(b, -448.f), 448.f); c = __builtin_fminf(__builtin_fmaxf(c, -448.f), 448.f); d = __builtin_fminf(__builtin_fmaxf(d, -448.f), 448.f);
    int p = __builtin_amdgcn_cvt_pk_fp8_f32(a, b, 0, false); p = __builtin_amdgcn_cvt_pk_fp8_f32(c, d, p, true); return (unsigned)p; }
constexpr float W8_SCALE = 32.0f, W8_INV = 1.0f / 32.0f;
__device__ __forceinline__ float fexp(float x) { return __builtin_amdgcn_exp2f(x * 1.44269504089f); }
__device__ __forceinline__ float flog(float x) { return __builtin_amdgcn_logf(x) * 0.69314718056f; }
__device__ __forceinline__ float frsq(float x) { return __builtin_amdgcn_rsqf(x); }
__device__ __forceinline__ float frcp(float x) { return __builtin_amdgcn_rcpf(x); }
__device__ __forceinline__ float fsigmoid(float x) { return frcp(1.0f + fexp(-x)); }
#define SWZ_XOR(x, k) __int_as_float(__builtin_amdgcn_ds_swizzle(__float_as_int(x), ((k) << 10) | 0x1F))
__device__ __forceinline__ float add_xor32(float v) { const auto r = __builtin_amdgcn_permlane32_swap(__float_as_uint(v), __float_as_uint(v), false, false); return __uint_as_float(r[0]) + __uint_as_float(r[1]); }
__device__ __forceinline__ float wave_sum(float v) {
    v += SWZ_XOR(v, 1); v += SWZ_XOR(v, 2); v += SWZ_XOR(v, 4); v += SWZ_XOR(v, 8); v += SWZ_XOR(v, 16);
    return __int_as_float(__builtin_amdgcn_readlane(__float_as_int(v), 0)) + __int_as_float(__builtin_amdgcn_readlane(__float_as_int(v), 32));
}
__device__ __forceinline__ int lane_now() { int l; asm volatile("v_mbcnt_lo_u32_b32 %0, -1, 0\n\tv_mbcnt_hi_u32_b32 %0, -1, %0" : "=v"(l)); return l; }
__device__ __forceinline__ int launder(int v) { asm volatile("" : "+v"(v)); return v; }
#define LDS_WAIT() asm volatile("s_waitcnt lgkmcnt(0)" ::: "memory")
#define LDSBAR() do { asm volatile("s_waitcnt lgkmcnt(0)" ::: "memory"); __builtin_amdgcn_s_barrier(); asm volatile("" ::: "memory"); } while (0)
#define VM_WAIT() asm volatile("s_waitcnt vmcnt(0)" ::: "memory")
__device__ __forceinline__ f32x2 gelu_pk(f32x2 v) {
    const f32x2 av = __builtin_elementwise_abs(v), d = av * 0.2316418882f + 1.0f;
    f32x2 t; t.x = __builtin_amdgcn_rcpf(d.x); t.y = __builtin_amdgcn_rcpf(d.y);
    f32x2 q = t * 0.5307027145f + (-0.7265760135f); q = q * t + 0.7107068705f; q = q * t + (-0.142248368f); q = q * t + 0.127414796f; q = q * t;
    const f32x2 s = (v * v) * (-0.72134752044f);
    f32x2 e; e.x = __builtin_amdgcn_exp2f(s.x); e.y = __builtin_amdgcn_exp2f(s.y);
    const f32x2 m = v * (q * e), r = v - m;
    f32x2 o; o.x = v.x < 0.f ? m.x : r.x; o.y = v.y < 0.f ? m.y : r.y; return o;
}

namespace pg8 {
constexpr int BM = 256, BK = 64, HALF = 128, HTB = HALF * BK * 2, STAGE_BYTES = 8 * HTB, BIAS_OFF = STAGE_BYTES + 8192;
__device__ __forceinline__ int lds_byte(int r, int c) { const int st = (r >> 4) * 2 + (c >> 5), rr = r & 15, cc = c & 31, ob = rr * 64 + cc * 2; return st * 1024 + (ob ^ (((ob >> 9) & 1) << 5)); }
__device__ __forceinline__ void stage_rc(int b, int& R, int& C) { const int st = b / 1024, sb = b % 1024, swz = sb ^ (((sb >> 9) & 1) << 5); R = (st >> 1) * 16 + swz / 64; C = (st & 1) * 32 + (swz % 64) / 2; }
__device__ __forceinline__ int perm32(int rho) { const int n = rho >> 4, i = rho & 15; return 8 * (i >> 2) + 4 * n + (i & 3); }

struct Unit { unsigned A, B0, B1; int r0, c0, aux, aux2, aux3; };
template <int nM, int nN> __device__ __forceinline__ void map_tile(int L, int& pm, int& pn) {
    constexpr int nwg = nM * nN; int wgid = L;
    { constexpr int q = nwg / 8, r = nwg % 8; const int xcd = wgid % 8, off = wgid / 8; wgid = (xcd < r ? xcd * (q + 1) : r * (q + 1) + (xcd - r) * q) + off; }
    static_assert(nM % 8 == 0, "row tiles come in groups of 8");
    constexpr int nig = 8 * nN; const int gid = wgid / nig, fm = gid * 8; constexpr int gsz = 8;
    pm = fm + ((wgid % nig) % gsz); pn = (wgid % nig) / gsz;
}

template <class Epi, class Sched, bool GATHER, bool F8 = false, bool ASMMMA = false>
__device__ __forceinline__ void gemm_phase(LAS unsigned char* lds, const __amdgpu_buffer_rsrc_t rsrc, const int tid_in, const int K, const Sched& S, const Epi& E) {
    const int tid = tid_in, wid = __builtin_amdgcn_readfirstlane(tid >> 6), lane = tid & 63, wr = wid >> 2, wc = wid & 3, fr = lane & 15, fq = lane >> 4;
    const int nt = F8 ? K / 128 : K / BK; const int rowpitch = F8 ? K : 2 * K;
    unsigned voffB[2], vA[2][2];
#pragma unroll
    for (int i = 0; i < 2; ++i) { int R, C; stage_rc(tid * 16 + i * 8192, R, C); const int Rb = Epi::PERM ? ((R & ~31) + perm32(R & 31)) : R;
        voffB[i] = (unsigned)(Rb * rowpitch + 2 * C);
        vA[0][i] = (unsigned)(R * rowpitch + 2 * C); vA[1][i] = vA[0][i]; }
    const unsigned hA = GATHER ? 0u : (unsigned)(HALF * rowpitch);
    const unsigned kstep = (unsigned)(BK * 2);
    const unsigned ldsw = (unsigned)wid * 1024u;
    const int f8o = (fq >> 1) * 1024 + fr * 64 + 32 * ((fq & 1) ^ (fr >> 3));
    const int aoff = F8 ? (wr * 4) * 2048 + f8o : lds_byte(wr * 64 + fr, fq * 8), boff = F8 ? (wc * 2) * 2048 + f8o : lds_byte(wc * 32 + fr, fq * 8);
    constexpr int KOFF = F8 ? 16 : 1024;
#define PG8_SA(b, h) (((b) * 2 + (h)) * HTB)
#define PG8_SB(b, h) ((4 + (b) * 2 + (h)) * HTB)
#define PG8_STAGE(bufoff, gbase, voff) do { _Pragma("unroll") for (int _i = 0; _i < 2; ++_i) \
        __builtin_amdgcn_raw_ptr_buffer_load_lds(rsrc, (LAS void*)(lds + (bufoff) + ldsw + _i * 8192), 16, (int)(voff)[_i], (int)(gbase), 0, 0); } while (0)
#define PG8_LDA(dst, b, h) do { _Pragma("unroll") for (int m = 0; m < 4; ++m) _Pragma("unroll") for (int k = 0; k < 2; ++k) dst[m][k] = *(const LAS bf16x8*)(lds + PG8_SA(b, h) + aoff + m * 2048 + k * KOFF); } while (0)
#define PG8_LDB(dst, b, h) do { _Pragma("unroll") for (int n = 0; n < 2; ++n) _Pragma("unroll") for (int k = 0; k < 2; ++k) dst[n][k] = *(const LAS bf16x8*)(lds + PG8_SB(b, h) + boff + n * 2048 + k * KOFF); } while (0)
#define PG8_CAT(lo, hi) __builtin_shufflevector(__builtin_bit_cast(i32x4, lo), __builtin_bit_cast(i32x4, hi), 0, 1, 2, 3, 4, 5, 6, 7)
#define PG8_MMA(ai, bj, At, Bt) do { __builtin_amdgcn_s_setprio(1); _Pragma("unroll") for (int m = 0; m < 4; ++m) _Pragma("unroll") for (int n = 0; n < 2; ++n) { \
        if constexpr (F8 && !ASMMMA) acc[ai][bj][m][n] = __builtin_amdgcn_mfma_scale_f32_16x16x128_f8f6f4(PG8_CAT(Bt[n][0], Bt[n][1]), PG8_CAT(At[m][0], At[m][1]), acc[ai][bj][m][n], 0, 0, 0, 0, 0, 0); \
        else if constexpr (F8) { const i32x8 b8_ = PG8_CAT(Bt[n][0], Bt[n][1]), a8_ = PG8_CAT(At[m][0], At[m][1]); \
            asm volatile("v_mfma_f32_16x16x128_f8f6f4 %0, %1, %2, %0" : "+v"(acc[ai][bj][m][n]) : "v"(b8_), "v"(a8_)); } \
        else { _Pragma("unroll") for (int k = 0; k < 2; ++k) acc[ai][bj][m][n] = __builtin_amdgcn_mfma_f32_16x16x32_bf16(Bt[n][k], At[m][k], acc[ai][bj][m][n], 0, 0, 0); } } \
        __builtin_amdgcn_s_setprio(0); } while (0)
#define PG8_WAIT_V(n) asm volatile("s_waitcnt vmcnt(" #n ")" ::: "memory")
#define PG8_WAIT_L(n) asm volatile("s_waitcnt lgkmcnt(" #n ")" ::: "memory")
#define PG8_BAR __builtin_amdgcn_s_barrier()
#define PG8_SCHED __builtin_amdgcn_sched_barrier(0)
    Unit cur, nxt; int ui = 0;
    if (!S.next(0, cur)) return;
    if constexpr (GATHER) S.a_offsets(cur, wid, vA);
    f32x4 acc[2][2][4][2];
#pragma unroll
    for (int a = 0; a < 2; ++a)
#pragma unroll
        for (int b = 0; b < 2; ++b)
#pragma unroll
            for (int m = 0; m < 4; ++m)
#pragma unroll
                for (int n = 0; n < 2; ++n) { acc[a][b][m][n] = (f32x4){0.f, 0.f, 0.f, 0.f}; if constexpr (F8) asm volatile("" : "+v"(acc[a][b][m][n])); }
    bf16x8 At[4][2], B0[2][2], B1[2][2];
    unsigned cA = cur.A, cB0 = cur.B0, cB1 = cur.B1;
    PG8_STAGE(PG8_SB(0, 0), cB0, voffB); PG8_STAGE(PG8_SB(0, 1), cB1, voffB); PG8_STAGE(PG8_SA(0, 0), cA, vA[0]); PG8_STAGE(PG8_SA(0, 1), cA + hA, vA[1]);
    if (wr == 1) PG8_BAR;
    PG8_WAIT_V(2); PG8_BAR;
    PG8_STAGE(PG8_SB(1, 0), cB0 + kstep, voffB); PG8_STAGE(PG8_SA(1, 0), cA + kstep, vA[0]); PG8_STAGE(PG8_SB(1, 1), cB1 + kstep, voffB);
    PG8_WAIT_V(6); PG8_BAR;
    for (;;) {
        const bool has_next = S.next(ui + 1, nxt);
        if constexpr (GATHER) { if (has_next) { unsigned nv[2][2]; S.a_offsets(nxt, wid, nv); *(LAS u32x4*)(lds + STAGE_BYTES + tid * 16) = (u32x4){nv[0][0], nv[0][1], nv[1][0], nv[1][1]}; } }
        const unsigned nA = has_next ? nxt.A : cA, nB0 = has_next ? nxt.B0 : cB0, nB1 = has_next ? nxt.B1 : cB1;
        if constexpr (Epi::BIAS) { if (wid == 0) E.bias_dma(lds + BIAS_OFF + (ui & 1) * 1024, cur); }
#pragma unroll 1
        for (int t = 0; t < nt; t += 2) {
            const bool last = (t == nt - 2);
            const unsigned a1 = cA + (unsigned)(t + 1) * kstep;
            const unsigned a2 = last ? nA : cA + (unsigned)(t + 2) * kstep;
            const unsigned b20 = last ? nB0 : cB0 + (unsigned)(t + 2) * kstep, b21 = last ? nB1 : cB1 + (unsigned)(t + 2) * kstep;
            const unsigned a3 = a2 + kstep, b30 = b20 + kstep, b31 = b21 + kstep;
            PG8_LDB(B0, 0, 0); PG8_LDB(B1, 0, 1); PG8_SCHED; PG8_LDA(At, 0, 0); PG8_STAGE(PG8_SA(1, 1), a1 + hA, vA[1]);
            if constexpr (GATHER) { if (last && has_next) { const u32x4 nv = *(const LAS u32x4*)(lds + STAGE_BYTES + tid * 16); vA[0][0] = nv.x; vA[0][1] = nv.y; vA[1][0] = nv.z; vA[1][1] = nv.w; } }
            PG8_WAIT_V(8); PG8_WAIT_L(0); PG8_BAR; PG8_MMA(0, 0, At, B0); PG8_MMA(0, 1, At, B1); PG8_BAR; PG8_SCHED;
            PG8_LDA(At, 0, 1); PG8_STAGE(PG8_SB(0, 0), b20, voffB); PG8_STAGE(PG8_SB(0, 1), b21, voffB); PG8_STAGE(PG8_SA(0, 0), a2, vA[0]);
            PG8_WAIT_V(8); PG8_WAIT_L(0); PG8_BAR; PG8_MMA(1, 0, At, B0); PG8_MMA(1, 1, At, B1); PG8_BAR; PG8_SCHED;
            PG8_LDB(B0, 1, 0); PG8_LDB(B1, 1, 1); PG8_SCHED; PG8_LDA(At, 1, 0); PG8_STAGE(PG8_SA(0, 1), a2 + hA, vA[1]);
            PG8_WAIT_V(8); PG8_WAIT_L(0); PG8_BAR; PG8_MMA(0, 0, At, B0); PG8_MMA(0, 1, At, B1); PG8_BAR; PG8_SCHED;
            PG8_LDA(At, 1, 1); PG8_STAGE(PG8_SB(1, 0), b30, voffB); PG8_STAGE(PG8_SB(1, 1), b31, voffB); PG8_STAGE(PG8_SA(1, 0), a3, vA[0]);
            PG8_WAIT_V(8); PG8_WAIT_L(0); PG8_BAR; PG8_MMA(1, 0, At, B0); PG8_MMA(1, 1, At, B1); PG8_BAR; PG8_SCHED;
        }
        if (wr == 0) PG8_BAR;
        if constexpr (F8 && ASMMMA) asm volatile("s_nop 15\n\ts_nop 15" ::: "memory");
        { const int le = lane_now(); if constexpr (Epi::BIAS) E(acc, cur, wr, wc, le & 15, le >> 4, lds + BIAS_OFF + (ui & 1) * 1024); else E(acc, cur, wr, wc, le & 15, le >> 4); }
        if (!has_next) break;
#pragma unroll
        for (int a = 0; a < 2; ++a)
#pragma unroll
            for (int b = 0; b < 2; ++b)
#pragma unroll
                for (int m = 0; m < 4; ++m)
#pragma unroll
                    for (int n = 0; n < 2; ++n) { acc[a][b][m][n] = (f32x4){0.f, 0.f, 0.f, 0.f}; if constexpr (F8) asm volatile("" : "+v"(acc[a][b][m][n])); }
        cur = nxt; cA = nA; cB0 = nB0; cB1 = nB1; ++ui;
        if (wr == 1) PG8_BAR;
    }
    PG8_WAIT_V(0);
    PG8_BAR;
#undef PG8_SA
#undef PG8_SB
#undef PG8_STAGE
#undef PG8_LDA
#undef PG8_LDB
#undef PG8_MMA
#undef PG8_CAT
#undef PG8_WAIT_V
#undef PG8_WAIT_L
#undef PG8_BAR
#undef PG8_SCHED
}
}

#define XB_TMO      128
#define XB_XCNT(j)  (256  + 64 * (j))
#define XB_XSUB(j)  (1280 + 64 * (j))
#define XB_XGEN(j)  (2304 + 64 * (j))
#define XB_TOP      3328
#define XB_TOPGEN   3392
#define XCD_BAR_WORDS 3456
#define XB_SPIN_CAP (1u << 18)
__device__ __forceinline__ unsigned xb_ld(unsigned* p)              { return __hip_atomic_load(p, __ATOMIC_RELAXED, __HIP_MEMORY_SCOPE_AGENT); }
__device__ __forceinline__ unsigned xb_add(unsigned* p, unsigned v) { return __hip_atomic_fetch_add(p, v, __ATOMIC_RELAXED, __HIP_MEMORY_SCOPE_AGENT); }
__device__ __forceinline__ unsigned xb_xcc_id() { return (unsigned)__builtin_amdgcn_s_getreg((3 << 11) | 20) & 0xFu; }
#define XB_SPIN(cond, bar) do { unsigned _sp = 0; while (cond) { __builtin_amdgcn_s_sleep(1); \
    if ((++_sp & 255u) == 0u) { if (xb_ld(&(bar)[XB_TMO])) break; if (_sp > XB_SPIN_CAP) { atomicAdd(&(bar)[XB_TMO], 1u); break; } } } } while (0)
struct XcdBarrier { unsigned* bar; unsigned x; volatile LAS unsigned* st; int wave; };
__device__ __forceinline__ bool xb_thread0(int wave) { return wave == 0 && lane_now() == 0; }
__device__ __forceinline__ XcdBarrier xcd_barrier_post(unsigned* bar, volatile LAS unsigned* st, int wave) {
    XcdBarrier b; b.bar = bar; b.x = xb_xcc_id(); b.st = st; b.wave = wave;
    if (xb_thread0(wave)) (void)xb_add(&bar[XB_XCNT(b.x)], 1u);
    return b;
}
__device__ __forceinline__ void xcd_barrier_complete(unsigned* bar, unsigned x, unsigned& nloc, unsigned& nx) {
    const unsigned G = gridDim.x * gridDim.y * gridDim.z;
    unsigned sum, cnt, mine, sp = 0u;
    for (;;) {
        sum = 0u; cnt = 0u; mine = 0u;
#pragma unroll
        for (unsigned j = 0; j < 16; ++j) { const unsigned c = xb_ld(&bar[XB_XCNT(j)]); sum += c; cnt += (c > 0u) ? 1u : 0u; mine = (j == x) ? c : mine; }
        if (sum == G) break;
        __builtin_amdgcn_s_sleep(1);
        if ((++sp & 255u) == 0u) { if (xb_ld(&bar[XB_TMO])) break; if (sp > XB_SPIN_CAP) { atomicAdd(&bar[XB_TMO], 1u); break; } }
    }
    nloc = mine > 0u ? mine : 1u; nx = cnt > 0u ? cnt : 1u;
}
__device__ __forceinline__ void xcd_barrier(const XcdBarrier& b) {
    asm volatile("s_waitcnt vmcnt(0)" ::: "memory");
    __syncthreads();
    if (xb_thread0(b.wave)) {
        unsigned* bar = b.bar;
        __builtin_amdgcn_s_waitcnt(0);
        unsigned nloc = b.st[0], nx = b.st[1];
        if (nloc == 0u) { xcd_barrier_complete(bar, b.x, nloc, nx); b.st[0] = nloc; b.st[1] = nx; }
        const unsigned old = xb_add(&bar[XB_XSUB(b.x)], 1u);
        const unsigned gen = old / nloc;
        if (old + 1u == (gen + 1u) * nloc) {
            __builtin_amdgcn_fence(__ATOMIC_RELEASE, "agent");
            asm volatile("s_waitcnt vmcnt(0)" ::: "memory");
            const unsigned og = xb_add(&bar[XB_TOP], 1u);
            const unsigned tg = og / nx;
            if (og + 1u == (tg + 1u) * nx) xb_add(&bar[XB_TOPGEN], 1u);
            else XB_SPIN(xb_ld(&bar[XB_TOPGEN]) == tg, bar);
            __builtin_amdgcn_fence(__ATOMIC_ACQUIRE, "agent");
            xb_add(&bar[XB_XGEN(b.x)], 1u);
            asm volatile("s_waitcnt vmcnt(0)" ::: "memory");
        } else {
            XB_SPIN(xb_ld(&bar[XB_XGEN(b.x)]) == gen, bar);
            __builtin_amdgcn_fence(__ATOMIC_ACQUIRE, "agent");
            asm volatile("s_waitcnt vmcnt(0)" ::: "memory");
        }
    }
    __syncthreads();
}

struct Args { const float* in[24]; float* out; unsigned char* ws; int pid_lo, pid_hi, dry, pad; };
struct Frame {
    LAS unsigned char* lds; volatile LAS unsigned* LC; gu32* ctl;
    int tid, lane, wave, G, blk;
    GAS float* out; GAS unsigned char* ws;
};
typedef const Args __attribute__((address_space(4))) CArgs;
__device__ __forceinline__ CArgs* argp() { CArgs* p = (CArgs*)__builtin_amdgcn_kernarg_segment_ptr(); asm volatile("" : "+s"(p)); return p; }
#define INP(i) (ap->in[i])
#define WSP(type, off) ((type*)(GAS type*)(F.ws + (off)))
#define OSP(type, off) ((type*)(GAS type*)((GAS unsigned char*)F.out + OUT_SCR + (off)))

__device__ __forceinline__ void p0_transpose_item(const float* W, int K, int N, bf16* WT, LAS float* scr, int item, int lane) {
    const int nblk = N / 32, kb = item / nblk, nb = item % nblk, k0 = 64 * kb, n0 = 32 * nb;
#pragma unroll 8
    for (int i = 0; i < 32; ++i) { const int kk = 2 * i + (lane >> 5); scr[kk * 33 + (lane & 31)] = W[(size_t)(k0 + kk) * N + n0 + (lane & 31)]; }
    LDS_WAIT(); asm volatile("" ::: "memory");
    const int c = lane & 7;
#pragma unroll
    for (int j = 0; j < 4; ++j) { const int n = (lane >> 3) + 8 * j; const LAS float* s = scr + (8 * c) * 33 + n;
        u32x4 o; o.x = cvt_pk_bf16(s[0 * 33], s[1 * 33]); o.y = cvt_pk_bf16(s[2 * 33], s[3 * 33]); o.z = cvt_pk_bf16(s[4 * 33], s[5 * 33]); o.w = cvt_pk_bf16(s[6 * 33], s[7 * 33]);
        *(u32x4*)(WT + (size_t)(n0 + n) * K + k0 + 8 * c) = o; }
    LDS_WAIT(); asm volatile("" ::: "memory");
}
__device__ __forceinline__ void p0_transpose_item8(const float* W, int K, int N, unsigned char* WT, LAS float* scr, int item, int lane, float scale) {
    const int nblk = N / 32, kb = item / nblk, nb = item % nblk, k0 = 64 * kb, n0 = 32 * nb;
#pragma unroll 8
    for (int i = 0; i < 32; ++i) { const int kk = 2 * i + (lane >> 5); scr[kk * 33 + (lane & 31)] = W[(size_t)(k0 + kk) * N + n0 + (lane & 31)]; }
    LDS_WAIT(); asm volatile("" ::: "memory");
    const int c = lane & 7;
#pragma unroll
    for (int j = 0; j < 4; ++j) { const int n = (lane >> 3) + 8 * j; const LAS float* p = scr + (8 * c) * 33 + n;
        u32x2 o; o.x = pack4_fp8(p[0 * 33] * scale, p[1 * 33] * scale, p[2 * 33] * scale, p[3 * 33] * scale); o.y = pack4_fp8(p[4 * 33] * scale, p[5 * 33] * scale, p[6 * 33] * scale, p[7 * 33] * scale);
        *(u32x2*)(WT + (size_t)(n0 + n) * K + k0 + 8 * c) = o; }
    LDS_WAIT(); asm volatile("" ::: "memory");
}
struct P0Item { const float* W; unsigned char* WT; int K, N, item; };
__device__ __forceinline__ void p0_item_load(const P0Item& t, int lane, f32x4 (&buf)[16]) {
    const int nblk = t.N / 64, kb = t.item / nblk, nb = t.item % nblk, k0 = 64 * kb, n0 = 64 * nb;
    const float* p = t.W + (size_t)(k0 + (lane >> 4)) * t.N + n0 + 4 * (lane & 15);
#pragma unroll
    for (int i = 0; i < 16; ++i) buf[i] = *(const f32x4*)(p + (size_t)(4 * i) * t.N);
}
__device__ __forceinline__ void p0_item_to_lds(LAS float* scr, int lane, const f32x4 (&buf)[16]) {
#pragma unroll
    for (int i = 0; i < 16; ++i) { LAS float* q = scr + (4 * i + (lane >> 4)) * 65 + 4 * (lane & 15); q[0] = buf[i].x; q[1] = buf[i].y; q[2] = buf[i].z; q[3] = buf[i].w; }
}
__device__ __forceinline__ void p0_item_finish(const P0Item& t, LAS float* scr, int lane, float scale) {
    const int nblk = t.N / 64, kb = t.item / nblk, nb = t.item % nblk, k0 = 64 * kb, n0 = 64 * nb;
    const int c = lane & 7;
#pragma unroll
    for (int j = 0; j < 8; ++j) { const int n = (lane >> 3) + 8 * j; const LAS float* p = scr + (8 * c) * 65 + n;
        u32x2 o; o.x = pack4_fp8(p[0 * 65] * scale, p[1 * 65] * scale, p[2 * 65] * scale, p[3 * 65] * scale); o.y = pack4_fp8(p[4 * 65] * scale, p[5 * 65] * scale, p[6 * 65] * scale, p[7 * 65] * scale);
        *(u32x2*)(t.WT + (size_t)(n0 + n) * t.K + k0 + 8 * c) = o; }
}
__device__ __forceinline__ void p0_prologue(Frame& F) {
    CArgs* ap = argp();
    float* mod = WSP(float, WS_MOD);
    if (F.blk < 96) {
        LAS float* S = (LAS float*)F.lds;
        { f32x4 cv[17];
#pragma unroll
          for (int i = 0; i < 17; ++i) { const int vi = F.tid + 512 * i; cv[i] = (vi < 8192) ? ((const f32x4*)INP(1))[vi] : ((const f32x4*)INP(3))[vi < 8448 ? vi - 8192 : 0]; }
          asm volatile("" ::: "memory");
#pragma unroll
          for (int i = 0; i < 17; ++i) { const int vi = F.tid + 512 * i; const f32x4 v = cv[i];
              if (vi < 8448) *(LAS f32x4*)(S + 4 * vi) = (f32x4){v.x * fsigmoid(v.x), v.y * fsigmoid(v.y), v.z * fsigmoid(v.z), v.w * fsigmoid(v.w)}; } }
        __syncthreads();
        const int n0 = F.blk * 64, col = n0 + F.lane; const float* wmod = INP(6);
        float acc[33];
#pragma unroll
        for (int r = 0; r < 33; ++r) acc[r] = 0.f;
        for (int k = 128 * F.wave; k < 128 * F.wave + 128; k += 8) {
            const float w0 = wmod[(size_t)(k + 0) * 6144 + col], w1 = wmod[(size_t)(k + 1) * 6144 + col], w2 = wmod[(size_t)(k + 2) * 6144 + col], w3 = wmod[(size_t)(k + 3) * 6144 + col];
            const float w4 = wmod[(size_t)(k + 4) * 6144 + col], w5 = wmod[(size_t)(k + 5) * 6144 + col], w6 = wmod[(size_t)(k + 6) * 6144 + col], w7 = wmod[(size_t)(k + 7) * 6144 + col];
            asm volatile("" ::: "memory");
#pragma unroll
            for (int r = 0; r < 33; ++r) { const f32x4 s = *(const LAS f32x4*)(S + r * 1024 + k), t = *(const LAS f32x4*)(S + r * 1024 + k + 4);
                acc[r] += (s.x * w0 + s.y * w1 + s.z * w2 + s.w * w3) + (t.x * w4 + t.y * w5 + t.z * w6 + t.w * w7); }
        }
        __syncthreads();
        LAS float* RED = (LAS float*)F.lds;
#pragma unroll
        for (int r = 0; r < 33; ++r) RED[(F.wave * 33 + r) * 64 + F.lane] = acc[r];
        __syncthreads();
        for (int idx = F.tid; idx < 33 * 64; idx += 512) { const int r = idx >> 6, l = idx & 63; float s = INP(7)[n0 + l];
#pragma unroll
            for (int w = 0; w < 8; ++w) s += RED[(w * 33 + r) * 64 + l];
            mod[r * 6144 + n0 + l] = s; }
        __syncthreads();
    }
    if (F.blk == 96) {
        float* lb = WSP(float, WS_LB);
        for (int j = F.tid; j < 1024; j += 512) { lb[j] = frcp(1.0f + fexp(INP(9)[1024 + j] - INP(9)[j])); lb[1024 + j] = frcp(1.0f + fexp(INP(10)[1024 + j] - INP(10)[j])); }
    }
    if (F.blk == 97) { bf16* whi = WSP(bf16, WS_WRT); bf16* wlo = whi + 32 * 1024; for (int idx = F.tid; idx < 32 * 1024; idx += 512) { const int e = idx >> 10, cc = idx & 1023; const float v = INP(17)[cc * 32 + e];
            const unsigned h = cvt_pk_bf16(v, 0.f) & 0xffffu; whi[idx] = (bf16)h; wlo[idx] = (bf16)(cvt_pk_bf16(v - bflo(h), 0.f) & 0xffffu); } }
    if (F.blk >= 98 && F.blk < 106) { bf16* wsb = WSP(bf16, WS_WSB); const int g = F.blk - 98; for (int idx = F.tid * 2; idx < 128 * 128; idx += 1024) { const float a = INP(12)[g * 16384 + idx], b = INP(12)[g * 16384 + idx + 1]; *(unsigned*)(wsb + g * 16384 + idx) = cvt_pk_bf16(a, b); } }
    LAS float* scr = (LAS float*)(F.lds + F.wave * 16384);
    const int gw = F.blk * 8 + F.wave, NGW = F.G * 8;
    constexpr int I_IN = 16 * (INW / 32), I_SQ = 16 * 32, I_W1 = 16 * 64, I_W2 = 16 * 32;
    constexpr int NITEMS = I_IN + 3 * I_SQ + NE * I_W1 + NE * I_W2;
    if (MK_P2_FP8 && MK_P5_FP8 && MK_P6_FP8) {
        constexpr int I_IN = 16 * (INW / 64), I_SQ = 16 * 16, I_W1 = 16 * 32, I_W2 = 16 * 16, NITEMS = I_IN + 3 * I_SQ + NE * I_W1 + NE * I_W2;
        LAS float* scr = (LAS float*)(F.lds + F.wave * 16896);
        auto decode = [&](int it) -> P0Item {
            int r = it;
            if (r < I_IN) return P0Item{INP(8), WSP(unsigned char, WS_WIN), D, INW, r}; r -= I_IN;
            if (r < I_SQ) return P0Item{INP(14), WSP(unsigned char, WS_WBA), D, D, r}; r -= I_SQ;
            if (r < I_SQ) return P0Item{INP(15), WSP(unsigned char, WS_WBB), D, D, r}; r -= I_SQ;
            if (r < I_SQ) return P0Item{INP(16), WSP(unsigned char, WS_WOUT), D, D, r}; r -= I_SQ;
            if (r < NE * I_W1) { const int e = r / I_W1; return P0Item{INP(19) + (size_t)e * D * 2 * FE, WSP(unsigned char, WS_W1) + (size_t)e * 2 * FE * D, D, 2 * FE, r % I_W1}; } r -= NE * I_W1;
            const int e = r / I_W2; return P0Item{INP(21) + (size_t)e * FE * D, WSP(unsigned char, WS_W2) + (size_t)e * D * FE, FE, D, r % I_W2}; };
        constexpr int P0_TAIL = (NITEMS * MK_P0_TAIL_PCT / 100) & ~7, NCOMMON = NITEMS - P0_TAIL;
        const int gw2 = (F.blk - 96) * 8 + F.wave, NGW2 = (F.G - 96) * 8;
        f32x4 buf[16];
        int it = gw;
        P0Item cur = decode(it < NITEMS ? it : 0);
        if (it < NITEMS) p0_item_load(cur, F.lane, buf);
        while (it < NITEMS) {
            p0_item_to_lds(scr, F.lane, buf);
            int nit = it + (it < NCOMMON ? NGW : NGW2);
            if (it < NCOMMON && nit >= NCOMMON) nit = (F.blk >= 96) ? NCOMMON + gw2 : NITEMS;
            P0Item nxt = cur;
            if (nit < NITEMS) { nxt = decode(nit); p0_item_load(nxt, F.lane, buf); }
            LDS_WAIT(); asm volatile("" ::: "memory");
            p0_item_finish(cur, scr, F.lane, W8_SCALE);
            LDS_WAIT(); asm volatile("" ::: "memory");
            cur = nxt; it = nit;
        }
    } else
    for (int it = gw; it < NITEMS; it += NGW) {
        int r = it;
        if (r < I_IN) { if (MK_P2_FP8) p0_transpose_item8(INP(8), D, INW, WSP(unsigned char, WS_WIN), scr, r, F.lane, W8_SCALE); else p0_transpose_item(INP(8), D, INW, WSP(bf16, WS_WIN), scr, r, F.lane); continue; } r -= I_IN;
        if (r < I_SQ) { if (MK_P5_FP8) p0_transpose_item8(INP(14), D, D, WSP(unsigned char, WS_WBA), scr, r, F.lane, W8_SCALE); else p0_transpose_item(INP(14), D, D, WSP(bf16, WS_WBA), scr, r, F.lane); continue; } r -= I_SQ;
        if (r < I_SQ) { if (MK_P5_FP8) p0_transpose_item8(INP(15), D, D, WSP(unsigned char, WS_WBB), scr, r, F.lane, W8_SCALE); else p0_transpose_item(INP(15), D, D, WSP(bf16, WS_WBB), scr, r, F.lane); continue; } r -= I_SQ;
        if (r < I_SQ) { if (MK_P6_FP8) p0_transpose_item8(INP(16), D, D, WSP(unsigned char, WS_WOUT), scr, r, F.lane, W8_SCALE); else p0_transpose_item(INP(16), D, D, WSP(bf16, WS_WOUT), scr, r, F.lane); continue; } r -= I_SQ;
        if (r < NE * I_W1) { const int e = r / I_W1; p0_transpose_item8(INP(19) + (size_t)e * D * 2 * FE, D, 2 * FE, WSP(unsigned char, WS_W1) + (size_t)e * 2 * FE * D, scr, r % I_W1, F.lane, W8_SCALE); continue; } r -= NE * I_W1;
        { const int e = r / I_W2; p0_transpose_item8(INP(21) + (size_t)e * FE * D, FE, D, WSP(unsigned char, WS_W2) + (size_t)e * D * FE, scr, r % I_W2, F.lane, W8_SCALE); }
    }
}

__device__ __forceinline__ void p1_rows(Frame& F, int grp) {
    CArgs* ap = argp(); const float* xin = INP(0); const float* ctxin = INP(2); const float* n1g = INP(4);
    const float* mod = WSP(float, WS_MOD);
    constexpr int ESZ = MK_P2_FP8 ? 1 : 2;
    const int gw = F.blk * 8 + F.wave, NGW = F.G * 8;
    for (int part = 0; part < (grp == 0 ? 2 : 1); ++part) {
        const int wps = part ? NGW : NGW / GB, seq = part ? 0 : gw / wps, wq = part ? gw : gw % wps;
        const int r0 = (part ? 0 : seq * T) + wq, r1 = part ? NCTX : ((seq < GB) ? (seq + 1) * T : 0), rstep = wps;
        f32x4 ma[4], mb[4]; int curb = -1;
        for (int r = r0; r < r1; r += 2 * rstep) {
            const int bsel = part ? 32 : grp * GB + (r >> 11);
            if (bsel != curb) { const float* mrow = mod + (size_t)bsel * 6144; curb = bsel;
#pragma unroll
                for (int j = 0; j < 4; ++j) { ma[j] = ((const f32x4*)n1g)[F.lane + 64 * j] * (((const f32x4*)(mrow + 1024))[F.lane + 64 * j] + 1.0f); mb[j] = ((const f32x4*)mrow)[F.lane + 64 * j]; } }
            const int rB = (r + rstep < r1) ? r + rstep : r;
            const float* srcA = part ? ctxin + (size_t)r * D : xin + ((size_t)grp * TG + r) * D; const float* srcB = part ? ctxin + (size_t)rB * D : xin + ((size_t)grp * TG + rB) * D;
            unsigned char* dbase = part ? WSP(unsigned char, WS_HC) : WSP(unsigned char, WS_H);
            f32x4 va[4], vb[4]; float sa = 0.f, sb = 0.f;
#pragma unroll
            for (int j = 0; j < 4; ++j) { va[j] = __builtin_nontemporal_load((const f32x4*)srcA + F.lane + 64 * j); vb[j] = __builtin_nontemporal_load((const f32x4*)srcB + F.lane + 64 * j); }
#pragma unroll
            for (int j = 0; j < 4; ++j) { sa += (va[j].x * va[j].x + va[j].y * va[j].y) + (va[j].z * va[j].z + va[j].w * va[j].w); sb += (vb[j].x * vb[j].x + vb[j].y * vb[j].y) + (vb[j].z * vb[j].z + vb[j].w * vb[j].w); }
            const float rsa = frsq(wave_sum(sa) * (1.0f / D) + EPS), rsb = frsq(wave_sum(sb) * (1.0f / D) + EPS);
#pragma unroll
            for (int j = 0; j < 4; ++j) {
                const f32x4 ha = va[j] * rsa * ma[j] + mb[j], hb = vb[j] * rsb * ma[j] + mb[j];
                if (MK_P2_FP8) { ((unsigned*)(dbase + (size_t)r * D * ESZ))[F.lane + 64 * j] = pack4_fp8(ha.x, ha.y, ha.z, ha.w); ((unsigned*)(dbase + (size_t)rB * D * ESZ))[F.lane + 64 * j] = pack4_fp8(hb.x, hb.y, hb.z, hb.w); }
                else { u32x2 o; o.x = cvt_pk_bf16(ha.x, ha.y); o.y = cvt_pk_bf16(ha.z, ha.w); ((u32x2*)(dbase + (size_t)r * D * ESZ))[F.lane + 64 * j] = o;
                       o.x = cvt_pk_bf16(hb.x, hb.y); o.y = cvt_pk_bf16(hb.z, hb.w); ((u32x2*)(dbase + (size_t)rB * D * ESZ))[F.lane + 64 * j] = o; } }
        }
    }
}

__device__ __forceinline__ void p10_final(Frame& F, int grp) {
    CArgs* ap = argp(); const float* fg = INP(23);
    const float* mod = WSP(float, WS_MOD); const bf16* ys = WSP(bf16, WS_YSLOT); const bf16* x1b = WSP(bf16, WS_T);
    const int gw = F.blk * 8 + F.wave, NGW = F.G * 8, wps = NGW / GB, seq = gw / wps, wq = gw % wps, r0 = seq * T + wq, r1 = (seq < GB) ? (seq + 1) * T : 0, rstep = wps;
    f32x4 mg[4], mf[4]; int curb = -1;
#pragma unroll
    for (int j = 0; j < 4; ++j) mf[j] = ((const f32x4*)fg)[F.lane + 64 * j];
#if !MK_SKIP_MOE
    const unsigned* spos = WSP(unsigned, WS_SPOS); const float* topw = WSP(float, WS_TOPW);
    const int lz = F.lane >> 6;
    u32x4 cur_sp[2]; f32x4 cur_tw[2];
    if (r0 < r1) { const int rB0 = (r0 + rstep < r1) ? r0 + rstep : r0; cur_sp[0] = ((const u32x4*)spos)[r0 + lz]; cur_sp[1] = ((const u32x4*)spos)[rB0 + lz]; cur_tw[0] = ((const f32x4*)topw)[r0 + lz]; cur_tw[1] = ((const f32x4*)topw)[rB0 + lz]; }
#endif
    for (int r = r0; r < r1; r += 2 * rstep) {
        const size_t grow = (size_t)grp * TG + r; const int bsel = (int)(grow >> 11);
        if (bsel != curb) { const float* g2 = mod + (size_t)bsel * 6144 + 5120; curb = bsel;
#pragma unroll
            for (int j = 0; j < 4; ++j) mg[j] = ((const f32x4*)g2)[F.lane + 64 * j]; }
        const int rr[2] = {r, (r + rstep < r1) ? r + rstep : r};
        f32x4 v[2][4]; float sq[2] = {0.f, 0.f};
#if !MK_SKIP_MOE
        unsigned yrow[2][4]; float yw[2][4];
#pragma unroll
        for (int q = 0; q < 2; ++q) { const u32x4 sp = cur_sp[q]; const f32x4 tw = cur_tw[q];
            yrow[q][0] = F.LC[LC_PT + (sp.x >> 16)] * 256u + (sp.x & 0xffffu); yrow[q][1] = F.LC[LC_PT + (sp.y >> 16)] * 256u + (sp.y & 0xffffu);
            yrow[q][2] = F.LC[LC_PT + (sp.z >> 16)] * 256u + (sp.z & 0xffffu); yrow[q][3] = F.LC[LC_PT + (sp.w >> 16)] * 256u + (sp.w & 0xffffu);
            yw[q][0] = tw.x; yw[q][1] = tw.y; yw[q][2] = tw.z; yw[q][3] = tw.w; }
        { const int rn = (r + 2 * rstep < r1) ? r + 2 * rstep : r, rnB = (rn + rstep < r1) ? rn + rstep : rn;
          cur_sp[0] = ((const u32x4*)spos)[rn + lz]; cur_sp[1] = ((const u32x4*)spos)[rnB + lz]; cur_tw[0] = ((const f32x4*)topw)[rn + lz]; cur_tw[1] = ((const f32x4*)topw)[rnB + lz]; }
#endif
        u32x2 xw[2][4];
#if !MK_SKIP_MOE
        u32x2 yv[2][4][4];
#endif
#pragma unroll
        for (int q = 0; q < 2; ++q)
#pragma unroll
            for (int j = 0; j < 4; ++j) { xw[q][j] = __builtin_nontemporal_load((const u32x2*)(x1b + (size_t)rr[q] * D) + F.lane + 64 * j);
#if !MK_SKIP_MOE
#pragma unroll
                for (int k = 0; k < 4; ++k) yv[q][k][j] = __builtin_nontemporal_load((const u32x2*)(ys + (size_t)yrow[q][k] * D) + F.lane + 64 * j);
#endif
            }
        asm volatile("" ::: "memory");
#pragma unroll
        for (int q = 0; q < 2; ++q)
#pragma unroll
            for (int j = 0; j < 4; ++j) {
                v[q][j] = (f32x4){bflo(xw[q][j].x), bfhi(xw[q][j].x), bflo(xw[q][j].y), bfhi(xw[q][j].y)};
#if !MK_SKIP_MOE
                f32x4 y = (f32x4){0.f, 0.f, 0.f, 0.f};
#pragma unroll
                for (int k = 0; k < 4; ++k) { const u32x2 w = yv[q][k][j]; y += (f32x4){bflo(w.x), bfhi(w.x), bflo(w.y), bfhi(w.y)} * yw[q][k]; }
                v[q][j] += mg[j] * y;
#endif
                sq[q] += (v[q][j].x * v[q][j].x + v[q][j].y * v[q][j].y) + (v[q][j].z * v[q][j].z + v[q][j].w * v[q][j].w); }
#pragma unroll
        for (int q = 0; q < 2; ++q) { const float rstd = frsq(wave_sum(sq[q]) * (1.0f / D) + EPS); float* orow = (float*)(F.out + ((size_t)grp * TG + rr[q]) * D);
#pragma unroll
            for (int j = 0; j < 4; ++j) __builtin_nontemporal_store(v[q][j] * rstd * mf[j], (f32x4*)orow + F.lane + 64 * j); }
    }
}

using pg8::Unit;
template <int NCT> struct SchedProj {
    int G, c, n_lat, n_ctx; unsigned H, HC, W; int ct0; static constexpr unsigned ES = MK_P2_FP8 ? 1 : 2;
    __device__ __forceinline__ bool next(int i, Unit& u) const {
        int L = i * G + c; int pm, pn;
        if (L < n_lat) { pg8::map_tile<TG / 256, NCT>(L, pm, pn); pn += ct0; u.A = H + (unsigned)pm * 256 * D * ES; u.B0 = W + (unsigned)pn * 256 * D * ES; u.B1 = u.B0 + 128u * D * ES; u.r0 = pm * 256; u.c0 = pn * 256; u.aux = 0; u.aux2 = 0; u.aux3 = 0; return true; }
        L -= n_lat;
        if (L < n_ctx) { pg8::map_tile<NCTX / 256, 12>(L, pm, pn); u.A = HC + (unsigned)pm * 256 * D * ES; u.B0 = W + (unsigned)(1024 + pn * 256) * D * ES; u.B1 = u.B0 + 128u * D * ES; u.r0 = pm * 256; u.c0 = 1024 + pn * 256; u.aux = 1; u.aux2 = 0; u.aux3 = 0; return true; }
        return false;
    }
};
struct EpiProj {
    static constexpr bool BIAS = false; static constexpr bool PERM = true;
    bf16* Z; bf16* ZC; const float* lb; float* vstat;
    template <int KIND> __device__ __forceinline__ void body(const f32x4 (&acc)[2][2][4][2], const Unit& u, int wr, int wc, int fr, int fq) const {
        bf16* base; int ldc, colo;
        if (u.aux) { base = ZC; ldc = 3072; colo = u.c0 - 1024; } else { base = Z; ldc = INW; colo = u.c0; }
        const int col0 = colo + wc * 32 + 8 * fq, gcol0 = u.c0 + wc * 32 + 8 * fq;
        float lbv[2][8];
        if constexpr (KIND == 2) { const float* lp = lb + ((u.c0 >> 10) - 2) * 1024 + (gcol0 & 1023);
#pragma unroll
            for (int bj = 0; bj < 2; ++bj) { const f32x4 a = *(const f32x4*)(lp + bj * 128), b = *(const f32x4*)(lp + bj * 128 + 4);
                lbv[bj][0] = a.x; lbv[bj][1] = a.y; lbv[bj][2] = a.z; lbv[bj][3] = a.w; lbv[bj][4] = b.x; lbv[bj][5] = b.y; lbv[bj][6] = b.z; lbv[bj][7] = b.w; } }
#pragma unroll
        for (int ai = 0; ai < 2; ++ai)
#pragma unroll
            for (int m = 0; m < 4; ++m) {
                const int row = u.r0 + ai * 128 + wr * 64 + m * 16 + fr;
                bf16* rowp = base + (size_t)row * ldc + col0;
                float s1 = 0.f, s2 = 0.f;
#pragma unroll
                for (int bj = 0; bj < 2; ++bj) {
                    float v[8];
#pragma unroll
                    for (int j = 0; j < 4; ++j) { v[j] = acc[ai][bj][m][0][j] * (MK_P2_FP8 ? W8_INV : 1.0f); v[4 + j] = acc[ai][bj][m][1][j] * (MK_P2_FP8 ? W8_INV : 1.0f); }
                    if constexpr (KIND == 0) {
#pragma unroll
                        for (int j = 0; j < 8; ++j) v[j] = v[j] * fsigmoid(v[j]);
                    } else if constexpr (KIND == 2) {
#pragma unroll
                        for (int j = 0; j < 8; ++j) v[j] = __builtin_amdgcn_logf(lbv[bj][j] + (1.0f - lbv[bj][j]) * fsigmoid(v[j]));
                    } else if constexpr (KIND == 3 || KIND == 4) {
#pragma unroll
                        for (int j = 0; j < 8; j += 2) { const f32x2 g = gelu_pk((f32x2){v[j], v[j + 1]}); v[j] = g.x; v[j + 1] = g.y; }
                    } else if constexpr (KIND == 5) {
#pragma unroll
                        for (int j = 0; j < 8; ++j) v[j] = fsigmoid(v[j]);
                    }
                    u32x4 w; w.x = cvt_pk_bf16(v[0], v[1]); w.y = cvt_pk_bf16(v[2], v[3]); w.z = cvt_pk_bf16(v[4], v[5]); w.w = cvt_pk_bf16(v[6], v[7]);
                    *(u32x4*)(rowp + bj * 128) = w;
                    if constexpr (KIND == 4) {
                        const float r0 = bflo(w.x), r1 = bfhi(w.x), r2 = bflo(w.y), r3 = bfhi(w.y), r4 = bflo(w.z), r5 = bfhi(w.z), r6 = bflo(w.w), r7 = bfhi(w.w);
                        s1 += ((r0 + r1) + (r2 + r3)) + ((r4 + r5) + (r6 + r7));
                        s2 += ((r0 * r0 + r1 * r1) + (r2 * r2 + r3 * r3)) + ((r4 * r4 + r5 * r5) + (r6 * r6 + r7 * r7)); }
                }
                if constexpr (KIND == 4) {
                    s1 += SWZ_XOR(s1, 16); s1 = add_xor32(s1); s2 += SWZ_XOR(s2, 16); s2 = add_xor32(s2);
                    if (fq == 0) *(f32x2*)(vstat + ((size_t)row * 16 + ((u.c0 - 6144) >> 8) * 4 + wc) * 2) = (f32x2){s1, s2}; }
            }
    }
    __device__ __forceinline__ void operator()(const f32x4 (&acc)[2][2][4][2], const Unit& u, int wr, int wc, int fr, int fq) const {
        const int seg = u.c0 >> 10;
        if (seg == 0) body<0>(acc, u, wr, wc, fr, fq);
        else if (seg == 1 || seg == 4) body<1>(acc, u, wr, wc, fr, fq);
        else if (seg == 2 || seg == 3) body<2>(acc, u, wr, wc, fr, fq);
        else if (seg == 5) body<3>(acc, u, wr, wc, fr, fq);
        else if (seg == 6) body<4>(acc, u, wr, wc, fr, fq);
        else body<5>(acc, u, wr, wc, fr, fq);
    }
};

struct SchedBranch {
    int G, c; unsigned YA, YB, WA, WB; static constexpr unsigned ES = MK_P5_FP8 ? 1 : 2;
    __device__ __forceinline__ bool next(int i, Unit& u) const {
        const int L = (i >> 1) * G + c, which = i & 1; if (L >= (TG / 256) * 4) return false;
        int pm, pn; pg8::map_tile<TG / 256, 4>(L, pm, pn);
        u.A = (which ? YB : YA) + (unsigned)pm * 256 * D * ES; u.B0 = (which ? WB : WA) + (unsigned)pn * 256 * D * ES; u.B1 = u.B0 + 128u * D * ES;
        u.r0 = pm * 256; u.c0 = pn * 256; u.aux = which; u.aux2 = 0; u.aux3 = 0; return true;
    }
};
struct EpiBranch {
    static constexpr bool BIAS = false; static constexpr bool PERM = true;
    const bf16* Z; bf16* Tb; bf16* M;
    template <int Q, bool AUX> __device__ __forceinline__ void loadq(const Unit& u, const size_t rowb, const int cb, const int gcol, u32x4 (&g)[2], u32x4 (&t)[2]) const {
        const size_t row = rowb + (Q >> 2) * 128 + (Q & 3) * 16;
#pragma unroll
        for (int bj = 0; bj < 2; ++bj) { g[bj] = *(const u32x4*)(Z + row * INW + gcol + cb + bj * 128); if constexpr (AUX) t[bj] = *(const u32x4*)(Tb + row * D + cb + bj * 128); }
        asm volatile("" ::: "memory");
    }
    template <int Q, bool AUX> __device__ __forceinline__ void compq(const f32x4 (&acc)[2][2][4][2], const Unit& u, const size_t rowb, const int cb, const u32x4 (&g)[2], const u32x4 (&t)[2]) const {
        constexpr int ai = Q >> 2, m = Q & 3; const size_t row = rowb + ai * 128 + m * 16;
#pragma unroll
        for (int bj = 0; bj < 2; ++bj) {
            const u32x4 gg = g[bj]; const unsigned gw[4] = {gg.x, gg.y, gg.z, gg.w};
            const u32x4 tt = t[bj]; const unsigned tw[4] = {tt.x, tt.y, tt.z, tt.w};
            float r[8];
#pragma unroll
            for (int j = 0; j < 8; ++j) { const float a = (j < 4 ? acc[ai][bj][m][0][j & 3] : acc[ai][bj][m][1][j & 3]) * (MK_P5_FP8 ? W8_INV : 1.0f);
                const float gv = (j & 1) ? bfhi(gw[j >> 1]) : bflo(gw[j >> 1]);
                r[j] = AUX ? ((j & 1) ? bfhi(tw[j >> 1]) : bflo(tw[j >> 1])) + a * gv : a * gv; }
            if constexpr (!AUX) { u32x4 o; o.x = cvt_pk_bf16(r[0], r[1]); o.y = cvt_pk_bf16(r[2], r[3]); o.z = cvt_pk_bf16(r[4], r[5]); o.w = cvt_pk_bf16(r[6], r[7]); *(u32x4*)(Tb + row * D + cb + bj * 128) = o; }
            else if (MK_P6_FP8) { u32x2 o; o.x = pack4_fp8(r[0], r[1], r[2], r[3]); o.y = pack4_fp8(r[4], r[5], r[6], r[7]); *(u32x2*)((unsigned char*)M + row * D + cb + bj * 128) = o; }
            else { u32x4 o; o.x = cvt_pk_bf16(r[0], r[1]); o.y = cvt_pk_bf16(r[2], r[3]); o.z = cvt_pk_bf16(r[4], r[5]); o.w = cvt_pk_bf16(r[6], r[7]); *(u32x4*)(M + row * D + cb + bj * 128) = o; } }
        asm volatile("" ::: "memory");
    }
    template <bool AUX> __device__ __forceinline__ void run(const f32x4 (&acc)[2][2][4][2], const Unit& u, int wr, int wc, int fr, int fq) const {
        const int gcol = AUX ? 8192 : 7168, cb = u.c0 + wc * 32 + 8 * fq; const size_t rowb = (size_t)(u.r0 + wr * 64 + fr);
        u32x4 gA[2], tA[2], gB[2], tB[2], gC[2], tC[2];
#pragma unroll
        for (int b = 0; b < 2; ++b) { tA[b] = (u32x4){0u, 0u, 0u, 0u}; tB[b] = tA[b]; tC[b] = tA[b]; }
        loadq<0, AUX>(u, rowb, cb, gcol, gA, tA); loadq<1, AUX>(u, rowb, cb, gcol, gB, tB);
        loadq<2, AUX>(u, rowb, cb, gcol, gC, tC); compq<0, AUX>(acc, u, rowb, cb, gA, tA);
        loadq<3, AUX>(u, rowb, cb, gcol, gA, tA); compq<1, AUX>(acc, u, rowb, cb, gB, tB);
        loadq<4, AUX>(u, rowb, cb, gcol, gB, tB); compq<2, AUX>(acc, u, rowb, cb, gC, tC);
        loadq<5, AUX>(u, rowb, cb, gcol, gC, tC); compq<3, AUX>(acc, u, rowb, cb, gA, tA);
        loadq<6, AUX>(u, rowb, cb, gcol, gA, tA); compq<4, AUX>(acc, u, rowb, cb, gB, tB);
        loadq<7, AUX>(u, rowb, cb, gcol, gB, tB); compq<5, AUX>(acc, u, rowb, cb, gC, tC);
        compq<6, AUX>(acc, u, rowb, cb, gA, tA); compq<7, AUX>(acc, u, rowb, cb, gB, tB);
    }
    __device__ __forceinline__ void operator()(const f32x4 (&acc)[2][2][4][2], const Unit& u, int wr, int wc, int fr, int fq) const {
        if (u.aux) run<true>(acc, u, wr, wc, fr, fq); else run<false>(acc, u, wr, wc, fr, fq);
    }
};

struct SchedOut {
    int G, c; unsigned MG, W; static constexpr unsigned ES = MK_P6_FP8 ? 1 : 2;
    __device__ __forceinline__ bool next(int i, Unit& u) const {
        const int L = i * G + c; if (L >= (TG / 256) * 4) return false;
        int pm, pn; pg8::map_tile<TG / 256, 4>(L, pm, pn);
        u.A = MG + (unsigned)pm * 256 * D * ES; u.B0 = W + (unsigned)pn * 256 * D * ES; u.B1 = u.B0 + 128u * D * ES; u.r0 = pm * 256; u.c0 = pn * 256; u.aux = 0; u.aux2 = 0; u.aux3 = 0; return true;
    }
};
struct EpiOut {
    static constexpr bool BIAS = false; static constexpr bool PERM = true;
    const float* x; bf16* x1b; const float* mod; int grp;
    template <int Q> __device__ __forceinline__ void loadq(const float* xb, f32x4 (&xv)[2][2]) const {
        const float* rp = xb + (size_t)((Q >> 2) * 128 + (Q & 3) * 16) * D;
#pragma unroll
        for (int bj = 0; bj < 2; ++bj) { xv[bj][0] = *(const f32x4*)(rp + bj * 128); xv[bj][1] = *(const f32x4*)(rp + bj * 128 + 4); }
        asm volatile("" ::: "memory");
    }
    template <int Q> __device__ __forceinline__ void compq(const f32x4 (&acc)[2][2][4][2], bf16* ob, const f32x4 (&gv)[2][2], const f32x4 (&xv)[2][2]) const {
        constexpr int ai = Q >> 2, m = Q & 3; bf16* rp = ob + (size_t)(ai * 128 + m * 16) * D;
#pragma unroll
        for (int bj = 0; bj < 2; ++bj) {
            const f32x4 r0 = xv[bj][0] + gv[bj][0] * (acc[ai][bj][m][0] * (MK_P6_FP8 ? W8_INV : 1.0f)), r1 = xv[bj][1] + gv[bj][1] * (acc[ai][bj][m][1] * (MK_P6_FP8 ? W8_INV : 1.0f));
            u32x4 o; o.x = cvt_pk_bf16(r0.x, r0.y); o.y = cvt_pk_bf16(r0.z, r0.w); o.z = cvt_pk_bf16(r1.x, r1.y); o.w = cvt_pk_bf16(r1.z, r1.w);
            *(u32x4*)(rp + bj * 128) = o; }
        asm volatile("" ::: "memory");
    }
    __device__ __forceinline__ void operator()(const f32x4 (&acc)[2][2][4][2], const Unit& u, int wr, int wc, int fr, int fq) const {
        const size_t grow0 = (size_t)grp * TG + u.r0;
        const float* g1 = mod + (grow0 >> 11) * 6144 + 2048;
        const int cb = u.c0 + wc * 32 + 8 * fq;
        const float* xb = x + (grow0 + wr * 64 + fr) * D + cb; bf16* ob = x1b + (size_t)(u.r0 + wr * 64 + fr) * D + cb;
        f32x4 gv[2][2];
#pragma unroll
        for (int bj = 0; bj < 2; ++bj) { gv[bj][0] = *(const f32x4*)(g1 + cb + bj * 128); gv[bj][1] = *(const f32x4*)(g1 + cb + bj * 128 + 4); }
        f32x4 xA[2][2], xB[2][2], xC[2][2];
        loadq<0>(xb, xA); loadq<1>(xb, xB);
        loadq<2>(xb, xC); compq<0>(acc, ob, gv, xA);
        loadq<3>(xb, xA); compq<1>(acc, ob, gv, xB);
        loadq<4>(xb, xB); compq<2>(acc, ob, gv, xC);
        loadq<5>(xb, xC); compq<3>(acc, ob, gv, xA);
        loadq<6>(xb, xA); compq<4>(acc, ob, gv, xB);
        loadq<7>(xb, xB); compq<5>(acc, ob, gv, xC);
        compq<6>(acc, ob, gv, xA); compq<7>(acc, ob, gv, xB);
    }
};

struct SchedMoe {
    int G, c, nct_shift; const volatile LAS unsigned* LC; unsigned Abase, W; const unsigned* list; bool second;
    __device__ __forceinline__ bool next(int i, Unit& u) const {
        const int x = c & 7, j = c >> 3, sr = i * 8 + x;
        const int rtg = nct_shift == 3 ? sr * 4 + (j >> 3) : sr * 8 + (j >> 2), ct = j & ((1 << nct_shift) - 1);
        if (rtg >= __builtin_amdgcn_readfirstlane((int)LC[LC_PT + 32])) return false;
        const int e = __builtin_amdgcn_readfirstlane((int)((LC[LC_EXPT + (rtg >> 2)] >> (8 * (rtg & 3))) & 0xffu));
        const int pt = __builtin_amdgcn_readfirstlane((int)LC[LC_PT + e]), rt = rtg - pt;
        u.aux = e; u.aux2 = rt * 256; u.aux3 = __builtin_amdgcn_readfirstlane((int)LC[LC_CNT + e]);
        if (!second) { u.A = Abase; u.B0 = W + (unsigned)(e * 2 * FE + 128 * ct) * D; u.B1 = W + (unsigned)(e * 2 * FE + FE + 128 * ct) * D; u.r0 = (pt + rt) * 256; u.c0 = 128 * ct; }
        else { u.A = Abase + (unsigned)(pt + rt) * 256 * FE; u.B0 = W + (unsigned)(e * D + 256 * ct) * FE; u.B1 = u.B0 + 128u * FE; u.r0 = (pt + rt) * 256; u.c0 = 256 * ct; }
        return true;
    }
    __device__ __forceinline__ void a_offsets(const Unit& u, const int wid, unsigned (&v)[2][2]) const {
        const int tid = wid * 64 + lane_now();
        int Rr[2], Cc[2];
#pragma unroll
        for (int i = 0; i < 2; ++i) pg8::stage_rc(tid * 16 + i * 8192, Rr[i], Cc[i]);
#pragma unroll
        for (int h = 0; h < 2; ++h)
#pragma unroll
            for (int i = 0; i < 2; ++i) { int idx = u.aux2 + h * 128 + Rr[i]; idx = idx < u.aux3 ? idx : u.aux3 - 1; const unsigned ent = list[(size_t)u.aux * TG + idx]; v[h][i] = (ent >> 2) * (unsigned)D + 2u * (unsigned)Cc[i]; }
    }
};
struct EpiMoe1 {
    static constexpr bool BIAS = true; static constexpr bool PERM = true;
    unsigned char* ACT; const float* b1;
    __device__ __forceinline__ void bias_dma(LAS unsigned char* dst, const Unit& u) const {
        const int l = lane_now(); const __amdgpu_buffer_rsrc_t r = __builtin_amdgcn_make_buffer_rsrc((void*)b1, 0, 0x7fffffff, 0x00020000);
        __builtin_amdgcn_raw_ptr_buffer_load_lds(r, (LAS void*)dst, 16, (int)((((l >> 5) * FE) + u.c0 + 4 * (l & 31)) * 4), (int)(u.aux * 2 * FE * 4), 0, 0);
    }
    __device__ __forceinline__ void operator()(const f32x4 (&acc)[2][2][4][2], const Unit& u, int wr, int wc, int fr, int fq, const LAS unsigned char* lb) const {
        const int col0 = u.c0 + wc * 32 + 8 * fq; const LAS float* bp = (const LAS float*)lb + wc * 32 + 8 * fq;
        f32x2 bg[4], bl[4];
        { const f32x4 a = *(const LAS f32x4*)bp, b = *(const LAS f32x4*)(bp + 4), c = *(const LAS f32x4*)(bp + 128), d = *(const LAS f32x4*)(bp + 128 + 4);
          bg[0] = (f32x2){a.x, a.y}; bg[1] = (f32x2){a.z, a.w}; bg[2] = (f32x2){b.x, b.y}; bg[3] = (f32x2){b.z, b.w};
          bl[0] = (f32x2){c.x, c.y}; bl[1] = (f32x2){c.z, c.w}; bl[2] = (f32x2){d.x, d.y}; bl[3] = (f32x2){d.z, d.w}; }
#pragma unroll
        for (int ai = 0; ai < 2; ++ai)
#pragma unroll
            for (int m = 0; m < 4; ++m) {
                const int row = u.r0 + ai * 128 + wr * 64 + m * 16 + fr;
                f32x2 v[4];
#pragma unroll
                for (int jp = 0; jp < 4; ++jp) {
                    const f32x4 ag4 = acc[ai][0][m][jp >> 1], al4 = acc[ai][1][m][jp >> 1];
                    const f32x2 ag = (jp & 1) ? (f32x2){ag4.z, ag4.w} : (f32x2){ag4.x, ag4.y}, al = (jp & 1) ? (f32x2){al4.z, al4.w} : (f32x2){al4.x, al4.y};
                    const f32x2 zg = ag * W8_INV + bg[jp], zl = al * W8_INV + bl[jp];
                    const f32x2 gate = __builtin_elementwise_min(zg, (f32x2){7.0f, 7.0f});
                    const f32x2 lin = __builtin_elementwise_max(__builtin_elementwise_min(zl, (f32x2){7.0f, 7.0f}), (f32x2){-7.0f, -7.0f});
                    const f32x2 arg = gate * (-1.702f * 1.44269504089f);
                    const f32x2 den = (f32x2){__builtin_amdgcn_exp2f(arg.x), __builtin_amdgcn_exp2f(arg.y)} + 1.0f;
                    const f32x2 p = gate * (f32x2){frcp(den.x), frcp(den.y)};
                    v[jp] = p * lin + p; }
                u32x2 w; { int p0 = __builtin_amdgcn_cvt_pk_fp8_f32(v[0].x, v[0].y, 0, false); p0 = __builtin_amdgcn_cvt_pk_fp8_f32(v[1].x, v[1].y, p0, true); int p1 = __builtin_amdgcn_cvt_pk_fp8_f32(v[2].x, v[2].y, 0, false); p1 = __builtin_amdgcn_cvt_pk_fp8_f32(v[3].x, v[3].y, p1, true); w.x = (unsigned)p0; w.y = (unsigned)p1; }
                *(u32x2*)(ACT + (size_t)row * FE + col0) = w;
            }
    }
};
struct EpiMoe2 {
    static constexpr bool BIAS = true; static constexpr bool PERM = true;
    bf16* YS; const float* b2;
    __device__ __forceinline__ void bias_dma(LAS unsigned char* dst, const Unit& u) const {
        const int l = lane_now(); const __amdgpu_buffer_rsrc_t r = __builtin_amdgcn_make_buffer_rsrc((void*)b2, 0, 0x7fffffff, 0x00020000);
        __builtin_amdgcn_raw_ptr_buffer_load_lds(r, (LAS void*)dst, 16, (int)((u.c0 + 4 * l) * 4), (int)(u.aux * D * 4), 0, 0);
    }
    __device__ __forceinline__ void operator()(const f32x4 (&acc)[2][2][4][2], const Unit& u, int wr, int wc, int fr, int fq, const LAS unsigned char* lb) const {
        const int col0 = u.c0 + wc * 32 + 8 * fq; const LAS float* bp = (const LAS float*)lb + wc * 32 + 8 * fq;
        float bv[2][8];
#pragma unroll
        for (int bj = 0; bj < 2; ++bj) { const f32x4 a = *(const LAS f32x4*)(bp + bj * 128), b = *(const LAS f32x4*)(bp + bj * 128 + 4);
            bv[bj][0] = a.x; bv[bj][1] = a.y; bv[bj][2] = a.z; bv[bj][3] = a.w; bv[bj][4] = b.x; bv[bj][5] = b.y; bv[bj][6] = b.z; bv[bj][7] = b.w; }
#pragma unroll
        for (int ai = 0; ai < 2; ++ai) {
#pragma unroll
            for (int m = 0; m < 4; ++m) {
                const int lr = ai * 128 + wr * 64 + m * 16 + fr;
                if (u.aux2 + lr < u.aux3) {
                    bf16* rowp = YS + (size_t)(u.r0 + lr) * D + col0;
#pragma unroll
                    for (int bj = 0; bj < 2; ++bj) {
                        float v[8];
#pragma unroll
                        for (int j = 0; j < 8; ++j) v[j] = (j < 4 ? acc[ai][bj][m][0][j & 3] : acc[ai][bj][m][1][j & 3]) * W8_INV + bv[bj][j];
                        u32x4 o; o.x = cvt_pk_bf16(v[0], v[1]); o.y = cvt_pk_bf16(v[2], v[3]); o.z = cvt_pk_bf16(v[4], v[5]); o.w = cvt_pk_bf16(v[6], v[7]);
                        *(u32x4*)(rowp + bj * 128) = o; }
                }
            }
        }
    }
};
__device__ __forceinline__ void moe_tables(Frame& F, int grp) {
    if (F.tid < 32) F.LC[LC_CNT + F.tid] = __hip_atomic_load(F.ctl + CW_CNT + (grp * 32 + F.tid) * 64, __ATOMIC_RELAXED, __HIP_MEMORY_SCOPE_AGENT);
    __syncthreads();
    if (F.tid == 0) { unsigned p = 0; for (int e = 0; e < 32; ++e) { F.LC[LC_PT + e] = p; p += (F.LC[LC_CNT + e] + 255u) >> 8; } F.LC[LC_PT + 32] = p; }
    __syncthreads();
    if (F.tid < (TG * 4 / 256 + 32) / 4) {
        unsigned wv = 0u;
        for (int q = 0; q < 4; ++q) { const unsigned rtg = 4u * F.tid + q; unsigned e = 0u; for (int k = 1; k < 32; ++k) e = (rtg >= F.LC[LC_PT + k]) ? (unsigned)k : e; wv |= e << (8 * q); }
        F.LC[LC_EXPT + F.tid] = wv; }
    __syncthreads();
}

constexpr int GL_QS = 0, GL_KS = 17408, GL_QB = 34816, GL_KBT = 52224, GL_VT = 70656, GL_P = 79872, GL_ST = 89088, GL_TOT = 106496, GL_EE = 110592;
constexpr int ST128 = 272, ST64 = 144;
#define MFMA16(a, b, c) __builtin_amdgcn_mfma_f32_16x16x32_bf16((a), (b), (c), 0, 0, 0)
__device__ __forceinline__ void p3_gla(Frame& F, int grp) {
    const bf16* Z = WSP(bf16, WS_Z); const bf16* ZC = WSP(bf16, WS_ZC);
    LAS unsigned char* L = F.lds;
    const int lane = F.lane, w = F.wave, fr = lane & 15, fq = lane >> 4;
    for (int it = F.blk; it < GB * 8 * 2 * 2; it += F.G) {
        const int vh = it & 1, dir = (it >> 1) & 1, h = (it >> 2) & 7, bl = it >> 5, b = grp * GB + bl;
        bf16* O = OSP(bf16, dir ? OS_OB : OS_OF);
        f32x4 accS[4];
#pragma unroll
        for (int i = 0; i < 4; ++i) accS[i] = (f32x4){0.f, 0.f, 0.f, 0.f};
        unsigned rq[8], rg[8]; unsigned short rv[8];
#define GLA_LOAD(st_) do { const int s__ = (st_); \
            if (s__ < 4) { const int cc = dir ? 3 - s__ : s__; const bf16* bp = ZC + (size_t)(b * CTXL + cc * 64 + 8 * w) * 3072; \
                _Pragma("unroll") for (int i = 0; i < 8; ++i) { rq[i] = 0u; rg[i] = *(const unsigned*)(bp + (size_t)i * 3072 + 1024 + dir * 1024 + h * 128 + 2 * lane); rv[i] = bp[(size_t)i * 3072 + h * 128 + vh * 64 + lane]; } } \
            else { const int lc = dir ? 35 - s__ : s__ - 4; const bf16* bp = Z + (size_t)(bl * T + lc * 64 + 8 * w) * INW; \
                _Pragma("unroll") for (int i = 0; i < 8; ++i) { rq[i] = *(const unsigned*)(bp + (size_t)i * INW + h * 128 + 2 * lane); rg[i] = *(const unsigned*)(bp + (size_t)i * INW + 2048 + dir * 1024 + h * 128 + 2 * lane); rv[i] = bp[(size_t)i * INW + 1024 + h * 128 + vh * 64 + lane]; } } } while (0)
        GLA_LOAD(0);
        for (int st = 0; st < 36; ++st) {
            const bool lat = st >= 4;
            float p0[8], p1[8], tot0 = 0.f, tot1 = 0.f;
            if (dir == 0) {
#pragma unroll
                for (int i = 0; i < 8; ++i) { tot0 += bflo(rg[i]); tot1 += bfhi(rg[i]); p0[i] = tot0; p1[i] = tot1; }
            } else {
#pragma unroll
                for (int i = 7; i >= 0; --i) { tot0 += bflo(rg[i]); tot1 += bfhi(rg[i]); p0[i] = tot0; p1[i] = tot1; }
            }
            *(LAS f32x2*)(L + GL_TOT + (w * 128 + 2 * lane) * 4) = (f32x2){tot0, tot1};
            __syncthreads();
            float off0 = 0.f, off1 = 0.f, bend0 = 0.f, bend1 = 0.f, bref0 = 0.f, bref1 = 0.f;
#pragma unroll
            for (int k = 0; k < 8; ++k) { const f32x2 t = *(const LAS f32x2*)(L + GL_TOT + (k * 128 + 2 * lane) * 4);
                const bool before = dir ? (k > w) : (k < w), inref = dir ? (k >= 4) : (k < 4);
                off0 += before ? t.x : 0.f; off1 += before ? t.y : 0.f; bend0 += t.x; bend1 += t.y; bref0 += inref ? t.x : 0.f; bref1 += inref ? t.y : 0.f; }
            const float eref0 = fexp(bref0), eref1 = fexp(bref1), eer0 = fexp(bend0 - bref0), eer1 = fexp(bend1 - bref1);
            float kb0[8], kb1[8];
#pragma unroll
            for (int i = 0; i < 8; ++i) {
                const float b0 = off0 + p0[i], b1 = off1 + p1[i];
                const float eq0 = fexp(b0 - bref0), eq1 = fexp(b1 - bref1), ek0 = frcp(eq0), ek1 = frcp(eq1);
                const float k0 = 1.0f - fexp(bflo(rg[i])), k1 = 1.0f - fexp(bfhi(rg[i]));
                const float ks0 = k0 * ek0, ks1 = k1 * ek1;
                kb0[i] = ks0 * eer0; kb1[i] = ks1 * eer1;
                if (lat) {
                    const float q0 = bflo(rq[i]), q1 = bfhi(rq[i]), qs0 = q0 * eq0, qs1 = q1 * eq1;
                    const int s = 8 * w + i;
                    *(LAS unsigned*)(L + GL_QS + s * ST128 + 4 * lane) = cvt_pk_bf16(qs0, qs1);
                    *(LAS unsigned*)(L + GL_KS + s * ST128 + 4 * lane) = cvt_pk_bf16(ks0, ks1);
                    *(LAS unsigned*)(L + GL_QB + s * ST128 + 4 * lane) = cvt_pk_bf16(qs0 * eref0, qs1 * eref1);
                }
            }
            { u32x4 o; o.x = cvt_pk_bf16(kb0[0], kb0[1]); o.y = cvt_pk_bf16(kb0[2], kb0[3]); o.z = cvt_pk_bf16(kb0[4], kb0[5]); o.w = cvt_pk_bf16(kb0[6], kb0[7]);
              *(LAS u32x4*)(L + GL_KBT + (2 * lane) * ST64 + 16 * w) = o;
              o.x = cvt_pk_bf16(kb1[0], kb1[1]); o.y = cvt_pk_bf16(kb1[2], kb1[3]); o.z = cvt_pk_bf16(kb1[4], kb1[5]); o.w = cvt_pk_bf16(kb1[6], kb1[7]);
              *(LAS u32x4*)(L + GL_KBT + (2 * lane + 1) * ST64 + 16 * w) = o;
              o.x = (unsigned)rv[0] | ((unsigned)rv[1] << 16); o.y = (unsigned)rv[2] | ((unsigned)rv[3] << 16); o.z = (unsigned)rv[4] | ((unsigned)rv[5] << 16); o.w = (unsigned)rv[6] | ((unsigned)rv[7] << 16);
              *(LAS u32x4*)(L + GL_VT + lane * ST64 + 16 * w) = o; }
            if (w == 0) *(LAS f32x2*)(L + GL_EE + 8 * lane) = (f32x2){fexp(bend0), fexp(bend1)};
            const int lc = dir ? 35 - st : st - 4;
            if (st + 1 < 36) GLA_LOAD(st + 1);
            __syncthreads();
            if (lat) {
#pragma unroll
                for (int x = 0; x < 2; ++x) {
                    const int id = 2 * w + x, sti = id >> 2, tti = id & 3;
                    f32x4 a = (f32x4){0.f, 0.f, 0.f, 0.f};
#pragma unroll
                    for (int ks = 0; ks < 4; ++ks) {
                        const bf16x8 fa = *(const LAS bf16x8*)(L + GL_KS + (16 * sti + fr) * ST128 + (32 * ks + 8 * fq) * 2);
                        const bf16x8 fb = *(const LAS bf16x8*)(L + GL_QS + (16 * tti + fr) * ST128 + (32 * ks + 8 * fq) * 2);
                        a = MFMA16(fa, fb, a); }
                    const int t = 16 * tti + fr, s0 = 16 * sti + 4 * fq;
                    float v[4];
#pragma unroll
                    for (int r = 0; r < 4; ++r) { const int s = s0 + r; const bool keep = dir ? (s >= t) : (s <= t); v[r] = keep ? a[r] : 0.f; }
                    u32x2 o; o.x = cvt_pk_bf16(v[0], v[1]); o.y = cvt_pk_bf16(v[2], v[3]);
                    *(LAS u32x2*)(L + GL_P + t * ST64 + 2 * s0) = o;
                }
                __syncthreads();
#pragma unroll
                for (int x = 0; x < 2; ++x) {
                    const int id = 2 * w + x, vti = id >> 2, tti = id & 3;
                    f32x4 o = (f32x4){0.f, 0.f, 0.f, 0.f};
                    if (MK_GLA_MODE != 3)
#pragma unroll
                    for (int ks = 0; ks < 2; ++ks) {
                        const bf16x8 fa = *(const LAS bf16x8*)(L + GL_VT + (16 * vti + fr) * ST64 + (32 * ks + 8 * fq) * 2);
                        const bf16x8 fb = *(const LAS bf16x8*)(L + GL_P + (16 * tti + fr) * ST64 + (32 * ks + 8 * fq) * 2);
                        o = MFMA16(fa, fb, o); }
                    if (MK_GLA_MODE != 2)
#pragma unroll
                    for (int ks = 0; ks < 4; ++ks) {
                        const bf16x8 fa = *(const LAS bf16x8*)(L + GL_ST + (16 * vti + fr) * ST128 + (32 * ks + 8 * fq) * 2);
                        const bf16x8 fb = *(const LAS bf16x8*)(L + GL_QB + (16 * tti + fr) * ST128 + (32 * ks + 8 * fq) * 2);
                        o = MFMA16(fa, fb, o); }
                    const int t = 16 * tti + fr; const size_t row = (size_t)bl * T + lc * 64 + t;
                    u32x2 ov; ov.x = cvt_pk_bf16(o[0], o[1]); ov.y = cvt_pk_bf16(o[2], o[3]);
                    *(u32x2*)(O + row * D + h * 128 + vh * 64 + 16 * vti + 4 * fq) = ov;
                }
            }
            { const f32x4 ee = *(const LAS f32x4*)(L + GL_EE + (16 * w + 4 * fq) * 4);
#pragma unroll
              for (int vt = 0; vt < 4; ++vt) accS[vt] *= ee;
#pragma unroll
              for (int ks = 0; ks < 2; ++ks) {
                  const bf16x8 fa = *(const LAS bf16x8*)(L + GL_KBT + (16 * w + fr) * ST64 + (32 * ks + 8 * fq) * 2);
#pragma unroll
                  for (int vt = 0; vt < 4; ++vt) { const bf16x8 fb = *(const LAS bf16x8*)(L + GL_VT + (16 * vt + fr) * ST64 + (32 * ks + 8 * fq) * 2); accS[vt] = MFMA16(fa, fb, accS[vt]); } } }
            __syncthreads();
#pragma unroll
            for (int vt = 0; vt < 4; ++vt) { u32x2 o; o.x = cvt_pk_bf16(accS[vt][0], accS[vt][1]); o.y = cvt_pk_bf16(accS[vt][2], accS[vt][3]);
                *(LAS u32x2*)(L + GL_ST + (16 * vt + fr) * ST128 + 2 * (16 * w + 4 * fq)) = o; }
        }
#undef GLA_LOAD
        __syncthreads();
    }
}

constexpr int NGLA = GB * 8 * 2;
constexpr int GF_QS = 0, GF_KS = 17408, GF_QB = 34816, GF_KBT = 52224, GF_VT = 70656, GF_P = 89088, GF_ST = 98304, GF_TOT = 133120, GF_EE = 137216;
static_assert(GF_EE + 512 <= RING_BYTES + 15360, "full scan LDS map");
__device__ __forceinline__ void p3_gla_full(Frame& F, int grp) {
    const bf16* Z = WSP(bf16, WS_Z); const bf16* ZC = WSP(bf16, WS_ZC);
    LAS unsigned char* L = F.lds;
    const int lane = F.lane, w = F.wave, fr = lane & 15, fq = lane >> 4;
    for (int it = F.blk; it < NGLA; it += F.G) {
        const int dir = it & 1, h = (it >> 1) & 7, bl = it >> 4, b = grp * GB + bl;
        bf16* O = OSP(bf16, dir ? OS_OB : OS_OF);
        f32x4 accS[8];
#pragma unroll
        for (int i = 0; i < 8; ++i) accS[i] = (f32x4){0.f, 0.f, 0.f, 0.f};
        unsigned rq[8], rg[8], rv[8];
#define GLF_LOAD(st_) do { const int s__ = (st_); \
            if (s__ < 4) { const int cc = dir ? 3 - s__ : s__; const bf16* bp = ZC + (size_t)(b * CTXL + cc * 64 + 8 * w) * 3072; \
                _Pragma("unroll") for (int i = 0; i < 8; ++i) { rq[i] = 0u; rg[i] = *(const unsigned*)(bp + (size_t)i * 3072 + 1024 + dir * 1024 + h * 128 + 2 * lane); rv[i] = *(const unsigned*)(bp + (size_t)i * 3072 + h * 128 + 2 * lane); } } \
            else { const int lc_ = dir ? 35 - s__ : s__ - 4; const bf16* bp = Z + (size_t)(bl * T + lc_ * 64 + 8 * w) * INW; \
                _Pragma("unroll") for (int i = 0; i < 8; ++i) { rq[i] = *(const unsigned*)(bp + (size_t)i * INW + h * 128 + 2 * lane); rg[i] = *(const unsigned*)(bp + (size_t)i * INW + 2048 + dir * 1024 + h * 128 + 2 * lane); rv[i] = *(const unsigned*)(bp + (size_t)i * INW + 1024 + h * 128 + 2 * lane); } } } while (0)
        GLF_LOAD(0);
        for (int st = 0; st < 36; ++st) {
            const bool lat = st >= 4;
            float p0[8], p1[8], tot0 = 0.f, tot1 = 0.f;
            if (dir == 0) {
#pragma unroll
                for (int i = 0; i < 8; ++i) { tot0 += bflo(rg[i]); tot1 += bfhi(rg[i]); p0[i] = tot0; p1[i] = tot1; }
            } else {
#pragma unroll
                for (int i = 7; i >= 0; --i) { tot0 += bflo(rg[i]); tot1 += bfhi(rg[i]); p0[i] = tot0; p1[i] = tot1; }
            }
            *(LAS f32x2*)(L + GF_TOT + (w * 128 + 2 * lane) * 4) = (f32x2){tot0, tot1};
            LDSBAR();
            float off0 = 0.f, off1 = 0.f, bend0 = 0.f, bend1 = 0.f, bref0 = 0.f, bref1 = 0.f;
#pragma unroll
            for (int k = 0; k < 8; ++k) { const f32x2 t = *(const LAS f32x2*)(L + GF_TOT + (k * 128 + 2 * lane) * 4);
                const bool before = dir ? (k > w) : (k < w), inref = dir ? (k >= 4) : (k < 4);
                off0 += before ? t.x : 0.f; off1 += before ? t.y : 0.f; bend0 += t.x; bend1 += t.y; bref0 += inref ? t.x : 0.f; bref1 += inref ? t.y : 0.f; }
            const float eer0 = __builtin_amdgcn_exp2f(bend0 - bref0), eer1 = __builtin_amdgcn_exp2f(bend1 - bref1);
            float kb0[8], kb1[8];
#pragma unroll
            for (int i = 0; i < 8; ++i) {
                const float b0 = off0 + p0[i], b1 = off1 + p1[i];
                const float eq0 = __builtin_amdgcn_exp2f(b0 - bref0), eq1 = __builtin_amdgcn_exp2f(b1 - bref1), ek0 = frcp(eq0), ek1 = frcp(eq1);
                const float k0 = 1.0f - __builtin_amdgcn_exp2f(bflo(rg[i])), k1 = 1.0f - __builtin_amdgcn_exp2f(bfhi(rg[i]));
                const float ks0 = k0 * ek0, ks1 = k1 * ek1;
                kb0[i] = ks0 * eer0; kb1[i] = ks1 * eer1;
                if (lat) {
                    const int sx = 8 * w + i;
                    *(LAS unsigned*)(L + GF_QS + sx * ST128 + 4 * lane) = cvt_pk_bf16(bflo(rq[i]) * eq0, bfhi(rq[i]) * eq1);
                    *(LAS unsigned*)(L + GF_KS + sx * ST128 + 4 * lane) = cvt_pk_bf16(ks0, ks1);
                }
            }
            { u32x4 o; o.x = cvt_pk_bf16(kb0[0], kb0[1]); o.y = cvt_pk_bf16(kb0[2], kb0[3]); o.z = cvt_pk_bf16(kb0[4], kb0[5]); o.w = cvt_pk_bf16(kb0[6], kb0[7]);
              *(LAS u32x4*)(L + GF_KBT + (2 * lane) * ST64 + 16 * w) = o;
              o.x = cvt_pk_bf16(kb1[0], kb1[1]); o.y = cvt_pk_bf16(kb1[2], kb1[3]); o.z = cvt_pk_bf16(kb1[4], kb1[5]); o.w = cvt_pk_bf16(kb1[6], kb1[7]);
              *(LAS u32x4*)(L + GF_KBT + (2 * lane + 1) * ST64 + 16 * w) = o;
              o.x = (rv[0] & 0xffffu) | (rv[1] << 16); o.y = (rv[2] & 0xffffu) | (rv[3] << 16); o.z = (rv[4] & 0xffffu) | (rv[5] << 16); o.w = (rv[6] & 0xffffu) | (rv[7] << 16);
              *(LAS u32x4*)(L + GF_VT + (2 * lane) * ST64 + 16 * w) = o;
              o.x = (rv[0] >> 16) | (rv[1] & 0xffff0000u); o.y = (rv[2] >> 16) | (rv[3] & 0xffff0000u); o.z = (rv[4] >> 16) | (rv[5] & 0xffff0000u); o.w = (rv[6] >> 16) | (rv[7] & 0xffff0000u);
              *(LAS u32x4*)(L + GF_VT + (2 * lane + 1) * ST64 + 16 * w) = o; }
            if (w == 0) *(LAS f32x2*)(L + GF_EE + 8 * lane) = (f32x2){__builtin_amdgcn_exp2f(bend0), __builtin_amdgcn_exp2f(bend1)};
            if (lat) {
                f32x4 br = (f32x4){0.f, 0.f, 0.f, 0.f};
#pragma unroll
                for (int k = 0; k < 4; ++k) br += *(const LAS f32x4*)(L + GF_TOT + ((dir ? k + 4 : k) * 128 + 16 * w + 4 * fq) * 4);
                const f32x4 er = (f32x4){__builtin_amdgcn_exp2f(br.x), __builtin_amdgcn_exp2f(br.y), __builtin_amdgcn_exp2f(br.z), __builtin_amdgcn_exp2f(br.w)};
#pragma unroll
                for (int vt = 0; vt < 8; ++vt) { const f32x4 sv = accS[vt] * er; u32x2 o; o.x = cvt_pk_bf16(sv[0], sv[1]); o.y = cvt_pk_bf16(sv[2], sv[3]);
                    *(LAS u32x2*)(L + GF_ST + (16 * vt + fr) * ST128 + 2 * (16 * w + 4 * fq)) = o; } }
            const int lc = dir ? 35 - st : st - 4;
            if (st + 1 < 36) GLF_LOAD(st + 1);
            LDSBAR();
            if (lat) {
#pragma unroll
                for (int x = 0; x < 2; ++x) {
                    const int id = 2 * w + x, sti = id >> 2, tti = id & 3;
                    f32x4 a = (f32x4){0.f, 0.f, 0.f, 0.f};
#pragma unroll
                    for (int ks = 0; ks < 4; ++ks) {
                        const bf16x8 fa = *(const LAS bf16x8*)(L + GF_KS + (16 * sti + fr) * ST128 + (32 * ks + 8 * fq) * 2);
                        const bf16x8 fb = *(const LAS bf16x8*)(L + GF_QS + (16 * tti + fr) * ST128 + (32 * ks + 8 * fq) * 2);
                        a = MFMA16(fa, fb, a); }
                    const int t = 16 * tti + fr, s0 = 16 * sti + 4 * fq;
                    float v[4];
#pragma unroll
                    for (int r = 0; r < 4; ++r) { const int sx = s0 + r; const bool keep = dir ? (sx >= t) : (sx <= t); v[r] = keep ? a[r] : 0.f; }
                    u32x2 o; o.x = cvt_pk_bf16(v[0], v[1]); o.y = cvt_pk_bf16(v[2], v[3]);
                    *(LAS u32x2*)(L + GF_P + t * ST64 + 2 * s0) = o;
                }
                LDSBAR();
                { const int vti = w;
                  bf16x8 fv[2], fs[4];
#pragma unroll
                  for (int ks = 0; ks < 2; ++ks) fv[ks] = *(const LAS bf16x8*)(L + GF_VT + (16 * vti + fr) * ST64 + (32 * ks + 8 * fq) * 2);
#pragma unroll
                  for (int ks = 0; ks < 4; ++ks) fs[ks] = *(const LAS bf16x8*)(L + GF_ST + (16 * vti + fr) * ST128 + (32 * ks + 8 * fq) * 2);
#pragma unroll
                  for (int x = 0; x < 4; ++x) {
                    const int tti = x;
                    f32x4 o = (f32x4){0.f, 0.f, 0.f, 0.f};
#pragma unroll
                    for (int ks = 0; ks < 2; ++ks) { const bf16x8 fb = *(const LAS bf16x8*)(L + GF_P + (16 * tti + fr) * ST64 + (32 * ks + 8 * fq) * 2); o = MFMA16(fv[ks], fb, o); }
#pragma unroll
                    for (int ks = 0; ks < 4; ++ks) { const bf16x8 fb = *(const LAS bf16x8*)(L + GF_QS + (16 * tti + fr) * ST128 + (32 * ks + 8 * fq) * 2); o = MFMA16(fs[ks], fb, o); }
                    const int t = 16 * tti + fr; const size_t row = (size_t)bl * T + lc * 64 + t;
                    u32x2 ov; ov.x = cvt_pk_bf16(o[0], o[1]); ov.y = cvt_pk_bf16(o[2], o[3]);
                    *(u32x2*)(O + row * D + h * 128 + 16 * vti + 4 * fq) = ov;
                  } }
            }
            { const f32x4 ee = *(const LAS f32x4*)(L + GF_EE + (16 * w + 4 * fq) * 4);
#pragma unroll
              for (int vt = 0; vt < 8; ++vt) accS[vt] *= ee;
#pragma unroll
              for (int ks = 0; ks < 2; ++ks) {
                  const bf16x8 fa = *(const LAS bf16x8*)(L + GF_KBT + (16 * w + fr) * ST64 + (32 * ks + 8 * fq) * 2);
#pragma unroll
                  for (int vt = 0; vt < 8; ++vt) { const bf16x8 fb = *(const LAS bf16x8*)(L + GF_VT + (16 * vt + fr) * ST64 + (32 * ks + 8 * fq) * 2); accS[vt] = MFMA16(fa, fb, accS[vt]); } } }
        }
#undef GLF_LOAD
        LDSBAR();
    }
}

__device__ __forceinline__ void p4_ya_cmlp(Frame& F, int grp) {
    const bf16* Z = WSP(bf16, WS_Z); const bf16* OFp = OSP(bf16, OS_OF); const bf16* OBp = OSP(bf16, OS_OB); bf16* YA = WSP(bf16, WS_YA); bf16* YB = WSP(bf16, WS_YB);
    const float* vstat = WSP(float, WS_VSTAT); const bf16* WSB = WSP(bf16, WS_WSB);
    LAS unsigned char* L = F.lds; CArgs* ap = argp(); const float* gng = INP(11); const float* bsp = INP(13);
    const int lane = F.lane, w = F.wave, fr = lane & 15, fq = lane >> 4, gw = F.blk * 8 + w, NGW = F.G * 8;
    { const int r0 = gw, r1 = TG, rstep = NGW;
      float gn[16];
      { const float* gp = gng + ((16 * lane) & 127);
#pragma unroll
        for (int i = 0; i < 16; i += 4) { const f32x4 t = *(const f32x4*)(gp + i); gn[i] = t.x; gn[i + 1] = t.y; gn[i + 2] = t.z; gn[i + 3] = t.w; } }
      for (int r = r0; r < r1; r += 2 * rstep) {
        const int rr[2] = {r, (r + rstep < r1) ? r + rstep : r};
        u32x4 la[2][2], lb[2][2], lg[2][2];
#pragma unroll
        for (int q = 0; q < 2; ++q)
#pragma unroll
            for (int hh = 0; hh < 2; ++hh) { la[q][hh] = ((const u32x4*)(OFp + (size_t)rr[q] * D) + 2 * lane)[hh]; lb[q][hh] = ((const u32x4*)(OBp + (size_t)rr[q] * D) + 2 * lane)[hh]; lg[q][hh] = ((const u32x4*)(Z + (size_t)rr[q] * INW + 4096) + 2 * lane)[hh]; }
#pragma unroll
        for (int q = 0; q < 2; ++q) {
            float o[16], gte[16]; float ss = 0.f;
#pragma unroll
            for (int hh = 0; hh < 2; ++hh)
#pragma unroll
                for (int j = 0; j < 4; ++j) { o[hh * 8 + 2 * j] = (MK_GLA_MODE == 1) ? 1.0f : bflo(la[q][hh][j]) + bflo(lb[q][hh][j]); o[hh * 8 + 2 * j + 1] = (MK_GLA_MODE == 1) ? 1.0f : bfhi(la[q][hh][j]) + bfhi(lb[q][hh][j]); { const float g0 = bflo(lg[q][hh][j]), g1 = bfhi(lg[q][hh][j]); gte[hh * 8 + 2 * j] = g0 * fsigmoid(g0); gte[hh * 8 + 2 * j + 1] = g1 * fsigmoid(g1); } }
#pragma unroll
            for (int i = 0; i < 16; ++i) ss += o[i] * o[i];
            ss += SWZ_XOR(ss, 1); ss += SWZ_XOR(ss, 2); ss += SWZ_XOR(ss, 4);
            const float rstd = frsq(ss * (1.0f / 128.0f) + EPS);
            u32x4 ov[2];
#pragma unroll
            for (int hh = 0; hh < 2; ++hh)
#pragma unroll
                for (int j = 0; j < 4; ++j) { const int i0 = hh * 8 + 2 * j; ov[hh][j] = cvt_pk_bf16(o[i0] * rstd * gn[i0] * gte[i0], o[i0 + 1] * rstd * gn[i0 + 1] * gte[i0 + 1]); }
            if (MK_P5_FP8) { float yv[16];
#pragma unroll
                for (int i = 0; i < 16; ++i) yv[i] = o[i] * rstd * gn[i] * gte[i];
                u32x4 o8; o8.x = pack4_fp8(yv[0], yv[1], yv[2], yv[3]); o8.y = pack4_fp8(yv[4], yv[5], yv[6], yv[7]); o8.z = pack4_fp8(yv[8], yv[9], yv[10], yv[11]); o8.w = pack4_fp8(yv[12], yv[13], yv[14], yv[15]);
                *((u32x4*)((unsigned char*)YA + (size_t)rr[q] * D) + lane) = o8; }
            else { u32x4* po = (u32x4*)(YA + (size_t)rr[q] * D) + 2 * lane; po[0] = ov[0]; po[1] = ov[1]; }
        }
      } }
    LAS f32x2* STAT = (LAS f32x2*)L; constexpr int VNT = 1024, WSL = 1024 + 128 * ST128;
    const int NIT = GB * 16 * 8;
    u32x2 rawv[8]; f32x2 rst[16]; int g_loaded = -1;
    const int c4 = F.tid & 31, sb = F.tid >> 5;
#define P4_PREFETCH(it_) do { const int g_ = (it_) & 7, n_ = ((it_) >> 3) & 15, bl_ = (it_) >> 7, tok_ = bl_ * T + n_ * 128; \
        { const bf16* zp = Z + (size_t)(tok_ + 8 * sb) * INW + 6144 + g_ * 128 + 4 * c4; \
          _Pragma("unroll") for (int i2 = 0; i2 < 8; ++i2) rawv[i2] = *(const u32x2*)(zp + (size_t)i2 * INW); } \
        if (F.tid < 128) { const f32x2* vs = (const f32x2*)vstat + (size_t)(tok_ + F.tid) * 16; _Pragma("unroll") for (int j = 0; j < 16; ++j) rst[j] = vs[j]; } } while (0)
    if (F.blk < NIT) P4_PREFETCH(F.blk);
    for (int it = F.blk; it < NIT; it += F.G) {
        const int g = it & 7, n = (it >> 3) & 15, bl = it >> 7, tok0 = bl * T + n * 128;
        if (g != g_loaded) {
            for (int idx = F.tid; idx < 128 * 16; idx += 512) { const int t = idx >> 4, ch = idx & 15; *(LAS u32x4*)(L + WSL + t * ST128 + ch * 16) = *(const u32x4*)(WSB + (size_t)g * 16384 + t * 128 + ch * 8); }
            g_loaded = g; }
        if (F.tid < 128) { float s1 = 0.f, s2 = 0.f;
#pragma unroll
            for (int j = 0; j < 16; ++j) { s1 += rst[j].x; s2 += rst[j].y; }
            const float mu = s1 * (1.0f / D); float var = s2 * (1.0f / D) - mu * mu; var = var > 0.f ? var : 0.f;
            STAT[F.tid] = (f32x2){mu, frsq(var + EPS)}; }
        LDSBAR();
        { f32x2 sv[8];
#pragma unroll
          for (int i2 = 0; i2 < 8; ++i2) sv[i2] = STAT[8 * sb + i2];
#pragma unroll
          for (int j = 0; j < 4; ++j) { float xv[8];
#pragma unroll
              for (int i2 = 0; i2 < 8; ++i2) { const unsigned wv = (j < 2) ? rawv[i2].x : rawv[i2].y; xv[i2] = (((j & 1) ? bfhi(wv) : bflo(wv)) - sv[i2].x) * sv[i2].y; }
              u32x4 o; o.x = cvt_pk_bf16(xv[0], xv[1]); o.y = cvt_pk_bf16(xv[2], xv[3]); o.z = cvt_pk_bf16(xv[4], xv[5]); o.w = cvt_pk_bf16(xv[6], xv[7]);
              const int row = 4 * c4 + j;
              *(LAS u32x4*)(L + VNT + row * ST128 + ((sb ^ ((row >> 3) & 7)) * 16)) = o; } }
        const int wq = w & 3, th = w >> 2;
        u32x4 uu[4]; float bsv[4];
#pragma unroll
        for (int tq = 0; tq < 4; ++tq) { const int t = 16 * (4 * th + tq) + fr; uu[tq] = *(const u32x4*)(Z + (size_t)(tok0 + t) * INW + 5120 + g * 128 + 32 * wq + 8 * fq); bsv[tq] = bsp[g * 128 + t]; }
        if (it + F.G < NIT) P4_PREFETCH(it + F.G);
        LDSBAR();
        f32x4 acc[2][4];
#pragma unroll
        for (int ct = 0; ct < 2; ++ct)
#pragma unroll
            for (int tq = 0; tq < 4; ++tq) acc[ct][tq] = (f32x4){0.f, 0.f, 0.f, 0.f};
        { const int swz = (4 * wq + (fr >> 2)) & 7;
          const int arow = (32 * wq + 8 * (fr >> 2) + (fr & 3)) * ST128;
          bf16x8 fa[2][2], fb[2][4];
#define P4_FRAGS(ks_, buf_) do { _Pragma("unroll") for (int ct = 0; ct < 2; ++ct) fa[buf_][ct] = *(const LAS bf16x8*)(L + VNT + arow + 4 * ct * ST128 + (((4 * (ks_) + fq) ^ swz) * 16)); \
            _Pragma("unroll") for (int tq = 0; tq < 4; ++tq) fb[buf_][tq] = *(const LAS bf16x8*)(L + WSL + (16 * (4 * th + tq) + fr) * ST128 + (32 * (ks_) + 8 * fq) * 2); } while (0)
          P4_FRAGS(0, 0);
#pragma unroll
          for (int ks = 0; ks < 4; ++ks) {
              if (ks < 3) P4_FRAGS(ks + 1, (ks + 1) & 1);
              __builtin_amdgcn_sched_barrier(0);
#pragma unroll
              for (int ct = 0; ct < 2; ++ct)
#pragma unroll
                  for (int tq = 0; tq < 4; ++tq) acc[ct][tq] = MFMA16(fa[ks & 1][ct], fb[ks & 1][tq], acc[ct][tq]);
              __builtin_amdgcn_sched_barrier(0); }
#undef P4_FRAGS
        }
#pragma unroll
        for (int tq = 0; tq < 4; ++tq) { const int t = 16 * (4 * th + tq) + fr, cc = g * 128 + 32 * wq + 8 * fq; const size_t row = (size_t)tok0 + t; const float bs = bsv[tq]; const u32x4 u4 = uu[tq];
            float y[8];
            y[0] = bflo(u4.x) * (acc[0][tq][0] + bs); y[1] = bfhi(u4.x) * (acc[0][tq][1] + bs); y[2] = bflo(u4.y) * (acc[0][tq][2] + bs); y[3] = bfhi(u4.y) * (acc[0][tq][3] + bs);
            y[4] = bflo(u4.z) * (acc[1][tq][0] + bs); y[5] = bfhi(u4.z) * (acc[1][tq][1] + bs); y[6] = bflo(u4.w) * (acc[1][tq][2] + bs); y[7] = bfhi(u4.w) * (acc[1][tq][3] + bs);
            if (MK_P5_FP8) { u32x2 o; o.x = pack4_fp8(y[0], y[1], y[2], y[3]); o.y = pack4_fp8(y[4], y[5], y[6], y[7]); *(u32x2*)((unsigned char*)YB + row * D + cc) = o; }
            else { u32x4 o; o.x = cvt_pk_bf16(y[0], y[1]); o.y = cvt_pk_bf16(y[2], y[3]); o.z = cvt_pk_bf16(y[4], y[5]); o.w = cvt_pk_bf16(y[6], y[7]); *(u32x4*)(YB + row * D + cc) = o; } }
        LDSBAR();
    }
#undef P4_PREFETCH
}

constexpr int P7_HI = 0, P7_LO = 65536, P7_LOG = 131072, P7_ENT = 131072 + 8704;
__device__ __forceinline__ void p7_router(Frame& F, int grp, const bool dry) {
    const float* mod = WSP(float, WS_MOD); const bf16* whi = WSP(bf16, WS_WRT); const bf16* wlo = whi + 32 * 1024; unsigned char* H2 = WSP(unsigned char, WS_H); unsigned* list = WSP(unsigned, WS_LIST); float* topw = WSP(float, WS_TOPW); unsigned* spos = WSP(unsigned, WS_SPOS);
    LAS unsigned char* L = F.lds; LAS float* LOG = (LAS float*)(L + P7_LOG); LAS unsigned* LENT = (LAS unsigned*)(L + P7_ENT);
    const int lane = F.lane, w = F.wave, fr = lane & 15, fq = lane >> 4; CArgs* ap = argp(); const float* n2g = INP(5); const float* brt = INP(18); const float* xin = INP(0); (void)xin;
    const bf16* x1b = WSP(bf16, WS_T);
    for (int chunk = F.blk; chunk < TG / 64; chunk += F.G) {
        if (F.tid < 32) F.LC[LC_LCNT + F.tid] = 0u;
        f32x4 ma[4], mb[4];
        { const float* mrow = mod + (((size_t)grp * TG + chunk * 64) >> 11) * 6144;
          f32x4 t0[4], t1[4];
#pragma unroll
          for (int j = 0; j < 4; ++j) { t0[j] = ((const f32x4*)n2g)[lane + 64 * j]; t1[j] = ((const f32x4*)(mrow + 4096))[lane + 64 * j]; mb[j] = ((const f32x4*)(mrow + 3072))[lane + 64 * j]; }
#pragma unroll
          for (int j = 0; j < 4; ++j) ma[j] = t0[j] * (t1[j] + 1.0f); }
        for (int pass = 0; pass < 2; ++pass) {
            { u32x2 xw[4][4];
#pragma unroll
              for (int rr = 0; rr < 4; ++rr) { const int rowl = chunk * 64 + pass * 32 + w * 4 + rr;
#pragma unroll
                  for (int j = 0; j < 4; ++j) xw[rr][j] = ((const u32x2*)(x1b + (size_t)rowl * D))[lane + 64 * j]; }
              asm volatile("" ::: "memory");
#pragma unroll
              for (int rr = 0; rr < 4; ++rr) {
                const int lr = w * 4 + rr, rowl = chunk * 64 + pass * 32 + lr;
                f32x4 v[4]; float s = 0.f;
#pragma unroll
                for (int j = 0; j < 4; ++j) { v[j] = (f32x4){bflo(xw[rr][j].x), bfhi(xw[rr][j].x), bflo(xw[rr][j].y), bfhi(xw[rr][j].y)}; s += (v[j].x * v[j].x + v[j].y * v[j].y) + (v[j].z * v[j].z + v[j].w * v[j].w); }
                const float rstd = frsq(wave_sum(s) * (1.0f / D) + EPS);
#pragma unroll
                for (int j = 0; j < 4; ++j) {
                    const f32x4 h = v[j] * rstd * ma[j] + mb[j];
                    u32x2 hi; hi.x = cvt_pk_bf16(h.x, h.y); hi.y = cvt_pk_bf16(h.z, h.w);
                    u32x2 lo; lo.x = cvt_pk_bf16(h.x - bflo(hi.x), h.y - bfhi(hi.x)); lo.y = cvt_pk_bf16(h.z - bflo(hi.y), h.w - bfhi(hi.y));
                    ((unsigned*)(H2 + (size_t)rowl * D))[lane + 64 * j] = pack4_fp8(h.x, h.y, h.z, h.w);
                    const int ch = ((lane >> 1) + 32 * j) ^ (lr & 15), off = lr * 2048 + ch * 16 + 8 * (lane & 1);
                    *(LAS u32x2*)(L + P7_HI + off) = hi; *(LAS u32x2*)(L + P7_LO + off) = lo; }
              } }
            bf16x8 bwh[16], bwl[16];
            { const int et = (w >> 1) & 1, kh = w & 1; const bf16* bh = whi + (size_t)(16 * et + fr) * 1024 + 8 * fq + 512 * kh; const bf16* bl = wlo + (size_t)(16 * et + fr) * 1024 + 8 * fq + 512 * kh;
#pragma unroll
              for (int k = 0; k < 16; ++k) { bwh[k] = *(const bf16x8*)(bh + 32 * k); bwl[k] = *(const bf16x8*)(bl + 32 * k); } }
            LDSBAR();
            { const int rt = w >> 2, et = (w >> 1) & 1, kh = w & 1, lr = 16 * rt + fr;
              f32x4 a0 = (f32x4){0.f, 0.f, 0.f, 0.f}, a1 = a0, a2 = a0;
              bf16x8 ahi[2], alo[2];
              { const int off = lr * 2048 + (((4 * (16 * kh) + fq) ^ (lr & 15)) * 16); ahi[0] = *(const LAS bf16x8*)(L + P7_HI + off); alo[0] = *(const LAS bf16x8*)(L + P7_LO + off); }
#pragma unroll
              for (int k = 0; k < 16; ++k) {
                  if (k < 15) { const int ks = 16 * kh + k + 1; const int off = lr * 2048 + (((4 * ks + fq) ^ (lr & 15)) * 16);
                      ahi[(k + 1) & 1] = *(const LAS bf16x8*)(L + P7_HI + off); alo[(k + 1) & 1] = *(const LAS bf16x8*)(L + P7_LO + off); }
                  __builtin_amdgcn_sched_barrier(0);
                  a0 = MFMA16(ahi[k & 1], bwh[k], a0); a1 = MFMA16(alo[k & 1], bwh[k], a1); a2 = MFMA16(ahi[k & 1], bwl[k], a2);
                  __builtin_amdgcn_sched_barrier(0); }
              const f32x4 acc = a0 + (a1 + a2);
              const float bias = kh ? 0.f : brt[16 * et + fr];
#pragma unroll
              for (int r = 0; r < 4; ++r) LOG[(kh * 32 + 16 * rt + 4 * fq + r) * 33 + 16 * et + fr] = acc[r] + bias; }
            LDSBAR();
            if (F.tid < 32) {
                const int lr = F.tid, rowl = chunk * 64 + pass * 32 + lr;
                float p[32];
#pragma unroll
                for (int e = 0; e < 32; ++e) p[e] = LOG[lr * 33 + e] + LOG[(32 + lr) * 33 + e];
#pragma unroll
                for (int e = 0; e < 32; ++e) { const unsigned ex = (unsigned)e; const unsigned b = __float_as_uint(p[e]); p[e] = __uint_as_float((b & ~31u) | ((b >> 31) ? ex : 31u - ex)); }
                float m0 = 0.f, sumexp = 0.f;
                LAS float* LTW = (LAS float*)(L + P7_ENT + 1024);
#pragma unroll
                for (int k = 0; k < 4; ++k) {
                    float m = p[0];
#pragma unroll
                    for (int e = 1; e < 32; ++e) m = __builtin_fmaxf(m, p[e]);
                    const unsigned mb = __float_as_uint(m); const int mi = (int)((mb >> 31) ? (mb & 31u) : 31u - (mb & 31u));
#pragma unroll
                    for (int e = 0; e < 32; ++e) p[e] = (p[e] == m) ? -3.0e38f : p[e];
                    if (k == 0) m0 = m;
                    const float ex_ = fexp(m - m0); sumexp += ex_;
                    const unsigned pos = __hip_atomic_fetch_add((LAS unsigned*)&F.LC[LC_LCNT + mi], 1u, __ATOMIC_RELAXED, __HIP_MEMORY_SCOPE_WORKGROUP);
                    LENT[(pass * 32 + lr) * 4 + k] = ((unsigned)mi << 16) | pos; LTW[lr * 4 + k] = ex_; }
                const float inv = frcp(sumexp); const f32x4 tw = *(const LAS f32x4*)(LTW + lr * 4);
                *(f32x4*)(topw + (size_t)rowl * 4) = tw * inv;
            }
            LDSBAR();
        }
        { const int t_ = launder(F.tid); if (t_ < 32 && !dry) F.LC[LC_LBASE + t_] = __hip_atomic_fetch_add(F.ctl + CW_CNT + (grp * 32 + t_) * 64, F.LC[LC_LCNT + t_], __ATOMIC_RELAXED, __HIP_MEMORY_SCOPE_AGENT); }
        LDSBAR();
        if (F.tid < 256 && !dry) { const unsigned en = LENT[F.tid], e = en >> 16, pos = F.LC[LC_LBASE + e] + (en & 0xffffu); const unsigned slot = (unsigned)(chunk * 64 + (F.tid >> 2)) * 4u + (F.tid & 3u); list[(size_t)e * TG + pos] = slot; spos[slot] = (e << 16) | pos; }
        LDSBAR();
    }
}

__global__ void __launch_bounds__(512, 2) fwd(Args args) {
    extern __shared__ __attribute__((aligned(16))) unsigned char lds[];
    Frame F;
    F.lds = (LAS unsigned char*)lds; F.LC = (volatile LAS unsigned*)(F.lds + LDSCTL_OFF);
    F.tid = threadIdx.x; F.lane = F.tid & 63; F.wave = __builtin_amdgcn_readfirstlane(F.tid >> 6); F.G = gridDim.x; F.blk = blockIdx.x;
    F.ws = (GAS unsigned char*)args.ws; F.ctl = (gu32*)(args.ws + WS_CTL); F.out = (GAS float*)args.out;
    for (int u = F.tid; u < 256; u += 512) F.LC[u] = 0u;
    __syncthreads();
#if !MK_PER_PHASE
    XcdBarrier bar = xcd_barrier_post((unsigned*)(F.ctl + CW_BAR), F.LC + LC_BAR, F.wave);
#define GRID_BAR() xcd_barrier(bar)
#else
#define GRID_BAR() do {} while (0)
#endif
    const int lo = args.pid_lo, hi = args.pid_hi;
#ifndef MK_MASK
#define MK_MASK 0xFFFF
#endif
#define IN(k) (lo <= (k) && (k) < hi)
#define PHON(p) ((MK_MASK >> (p)) & 1)
#define SEAM(k) do { if (IN((k) + 1)) GRID_BAR(); } while (0)
#define MKRSRC() __builtin_amdgcn_make_buffer_rsrc((void*)F.ws, 0, 0x7fffffff, 0x00020000)
#define REFRESH() do { F.lane = lane_now(); F.tid = F.wave * 64 + F.lane; \
        { GAS unsigned char* w_ = F.ws; asm volatile("" : "+s"(w_)); F.ws = w_; GAS float* o_ = F.out; asm volatile("" : "+s"(o_)); F.out = o_; } } while (0)
    LAS unsigned char* ring = F.lds;
    if (PHON(0) && IN(0)) { REFRESH(); p0_prologue(F); SEAM(0); }
    for (int grp = 0; grp < NG; ++grp) {
        const int pb = 1 + grp * NPH;
#if !MK_SKIP_MIXER
        if (PHON(1) && IN(pb + 0)) { if (grp == 0 || MK_PER_PHASE || MK_TIME_PHASE >= 0) { REFRESH(); p1_rows(F, grp); SEAM(pb + 0); } }
        if (PHON(2) && IN(pb + 1)) {
            REFRESH();
            SchedProj<16> S{F.G, F.blk, (TG / 256) * 16, grp == 0 ? (NCTX / 256) * 12 : 0, (unsigned)WS_H, (unsigned)WS_HC, (unsigned)WS_WIN, 0};
            EpiProj E{WSP(bf16, WS_Z), WSP(bf16, WS_ZC), WSP(float, WS_LB), WSP(float, WS_VSTAT)};
            pg8::gemm_phase<EpiProj, SchedProj<16>, false, MK_P2_FP8 != 0>(ring, MKRSRC(), F.tid, D, S, E);
            SEAM(pb + 1);
        }
        if (PHON(3) && IN(pb + 2)) {
            REFRESH();
            p3_gla_full(F, grp);
            REFRESH();
            { SchedProj<20> S{F.G, F.blk, (TG / 256) * 20, 0, (unsigned)WS_H, (unsigned)WS_HC, (unsigned)WS_WIN, 16};
              EpiProj E{WSP(bf16, WS_Z), WSP(bf16, WS_ZC), WSP(float, WS_LB), WSP(float, WS_VSTAT)};
              pg8::gemm_phase<EpiProj, SchedProj<20>, false, MK_P2_FP8 != 0>(ring, MKRSRC(), F.tid, D, S, E); }
            SEAM(pb + 2);
        }
        if (PHON(4) && IN(pb + 3)) { for (int rep_ = 0; rep_ < REPS(4); ++rep_) { REFRESH(); p4_ya_cmlp(F, grp); } SEAM(pb + 3); }
        if (PHON(5) && IN(pb + 4)) {
            REFRESH();
            SchedBranch S{F.G, F.blk, (unsigned)WS_YA, (unsigned)WS_YB, (unsigned)WS_WBA, (unsigned)WS_WBB};
            EpiBranch E{WSP(bf16, WS_Z), OSP(bf16, OS_TB), WSP(bf16, WS_MERGED)};
            for (int rep_ = 0; rep_ < REPS(5); ++rep_) pg8::gemm_phase<EpiBranch, SchedBranch, false, MK_P5_FP8 != 0, MK_P5_FP8 != 0>(ring, MKRSRC(), F.tid, D, S, E);
            SEAM(pb + 4);
        }
        if (PHON(6) && IN(pb + 5)) {
            REFRESH();
            SchedOut S{F.G, F.blk, (unsigned)WS_MERGED, (unsigned)WS_WOUT};
            EpiOut E{argp()->in[0], WSP(bf16, WS_T), WSP(float, WS_MOD), grp};
            for (int rep_ = 0; rep_ < REPS(6); ++rep_) pg8::gemm_phase<EpiOut, SchedOut, false, MK_P6_FP8 != 0, MK_P6_FP8 != 0>(ring, MKRSRC(), F.tid, D, S, E);
            SEAM(pb + 5);
        }
#else
        if (IN(pb + 0)) SEAM(pb + 0);
        if (IN(pb + 1)) SEAM(pb + 1);
        if (IN(pb + 2)) SEAM(pb + 2);
        if (IN(pb + 3)) SEAM(pb + 3);
        if (IN(pb + 4)) SEAM(pb + 4);
        if (IN(pb + 5)) SEAM(pb + 5);
#endif
#if !MK_SKIP_MOE
        if (PHON(7) && IN(pb + 6)) { REFRESH(); p7_router(F, grp, args.dry != 0); SEAM(pb + 6); }
        if (PHON(8) && IN(pb + 7)) {
            REFRESH(); moe_tables(F, grp);
            SchedMoe S{F.G, F.blk, 3, F.LC, (unsigned)WS_H, (unsigned)WS_W1, WSP(unsigned, WS_LIST), false};
            EpiMoe1 E{WSP(unsigned char, WS_ACT), argp()->in[20]};
            for (int rep_ = 0; rep_ < REPS(8); ++rep_) pg8::gemm_phase<EpiMoe1, SchedMoe, true, true>(ring, MKRSRC(), F.tid, D, S, E);
            SEAM(pb + 7);
        }
        if (PHON(9) && IN(pb + 8)) {
            REFRESH(); moe_tables(F, grp);
            SchedMoe S{F.G, F.blk, 2, F.LC, (unsigned)WS_ACT, (unsigned)WS_W2, WSP(unsigned, WS_LIST), true};
            EpiMoe2 E{WSP(bf16, WS_YSLOT), argp()->in[22]};
            for (int rep_ = 0; rep_ < REPS(9); ++rep_) pg8::gemm_phase<EpiMoe2, SchedMoe, false, true, true>(ring, MKRSRC(), F.tid, FE, S, E);
            SEAM(pb + 8);
        }
#else
        if (IN(pb + 6)) SEAM(pb + 6);
        if (IN(pb + 7)) SEAM(pb + 7);
        if (IN(pb + 8)) SEAM(pb + 8);
#endif
        if (PHON(10) && IN(pb + 9)) { REFRESH(); if (MK_PER_PHASE || MK_TIME_PHASE >= 0) moe_tables(F, grp); p10_final(F, grp); if (!MK_PER_PHASE && MK_TIME_PHASE < 0 && grp + 1 < NG) { REFRESH(); p1_rows(F, grp + 1); } SEAM(pb + 9); }
    }
}

extern "C" void kernel_launch(void* const* d_in, const int* in_sizes, int n_in, void* d_out, int out_size, void* d_ws, size_t ws_size, hipStream_t stream) {
    static int grid = 0;
    if (grid == 0) {
        if (n_in != 24 || out_size != NTOK * D || ws_size < WS_END) { fprintf(stderr, "kernel_launch: unexpected shapes (n_in %d out %d ws %zu)\n", n_in, out_size, ws_size); grid = -1; return; }
        int dev = 0, cus = 0, per_cu = 0;
        if (hipGetDevice(&dev) != hipSuccess || hipDeviceGetAttribute(&cus, hipDeviceAttributeMultiprocessorCount, dev) != hipSuccess) { grid = -1; return; }
        if (hipFuncSetAttribute((const void*)fwd, hipFuncAttributeMaxDynamicSharedMemorySize, LDS_BYTES) != hipSuccess) { fprintf(stderr, "kernel_launch: hipFuncSetAttribute failed\n"); grid = -1; return; }
        if (hipOccupancyMaxActiveBlocksPerMultiprocessor(&per_cu, (const void*)fwd, 512, LDS_BYTES) != hipSuccess || per_cu < 1) fprintf(stderr, "kernel_launch: occupancy query reports %d\n", per_cu);
        (void)hipGetLastError();
        grid = cus;
    }
    if (grid < 0) return;
    if (hipMemsetAsync((char*)d_ws + WS_CTL, 0, CTL_ZERO_BYTES, stream) != hipSuccess) return;
    Args a{}; a.dry = 0; a.pad = 0;
    for (int i = 0; i < 24; ++i) a.in[i] = (const float*)d_in[i];
    a.out = (float*)d_out; a.ws = (unsigned char*)d_ws;
#if MK_PER_PHASE
    for (int pid = 0; pid < NPID; ++pid) { a.pid_lo = pid; a.pid_hi = pid + 1; hipLaunchKernelGGL(fwd, dim3(grid), dim3(512), LDS_BYTES, stream, a); }
#else
    a.pid_lo = 0; a.pid_hi = NPID; hipLaunchKernelGGL(fwd, dim3(grid), dim3(512), LDS_BYTES, stream, a);
#if MK_TIME_PHASE >= 0
    for (int g = 0; g < (MK_TIME_PHASE == 0 ? 1 : NG); ++g) { a.pid_lo = MK_TIME_PHASE == 0 ? 0 : 1 + g * NPH + (MK_TIME_PHASE - 1); a.pid_hi = a.pid_lo + 1; a.dry = 1; hipLaunchKernelGGL(fwd, dim3(grid), dim3(512), LDS_BYTES, stream, a); }
#endif
#endif
    const hipError_t le = hipPeekAtLastError();
    if (le != hipSuccess) fprintf(stderr, "kernel_launch: launch failed: %s\n", hipGetErrorName(le));
}
```

```cpp
#include <hip/hip_runtime.h>
#include <cstdio>
#include <cstdint>

#ifndef MK_P0_TAIL_PCT
#define MK_P0_TAIL_PCT 12
#endif
#ifndef MK_PER_PHASE
#define MK_PER_PHASE 0
#endif
#ifndef MK_SKIP_MIXER
#define MK_SKIP_MIXER 0
#endif
#ifndef MK_NO_A
#define MK_NO_A 0
#endif
#ifndef MK_NO_B
#define MK_NO_B 0
#endif
#ifndef MK_GLA_MODE
#define MK_GLA_MODE 0
#endif
#ifndef MK_REP_PHASE
#define MK_REP_PHASE -1
#endif
#define REPS(k) ((MK_REP_PHASE == (k)) ? 2 : 1)
#ifndef MK_P2_FP8
#define MK_P2_FP8 1
#endif
#ifndef MK_TIME_PHASE
#define MK_TIME_PHASE -1
#endif
#ifndef MK_P6_FP8
#define MK_P6_FP8 1
#endif
#ifndef MK_P5_FP8
#define MK_P5_FP8 1
#endif
#ifndef MK_SKIP_MOE
#define MK_SKIP_MOE 0
#endif

#define GAS __attribute__((address_space(1)))
#define LAS __attribute__((address_space(3)))
typedef unsigned short bf16;
typedef short bf16x8 __attribute__((ext_vector_type(8)));
typedef float f32x4 __attribute__((ext_vector_type(4)));
typedef float f32x2 __attribute__((ext_vector_type(2)));
typedef unsigned u32x4 __attribute__((ext_vector_type(4)));
typedef unsigned u32x2 __attribute__((ext_vector_type(2)));
typedef GAS unsigned gu32;

constexpr int D = 1024, NB = 32, T = 2048, CTXL = 256, NTOK = NB * T, NCTX = NB * CTXL;
constexpr int GB = 16, NG = NB / GB, TG = GB * T;
constexpr int INW = 9216, NE = 32, FE = 1024, TOPK = 4;
constexpr float EPS = 1e-6f;
constexpr int TGM = NTOK;
constexpr int NPH = 6;
constexpr int NPID = 1 + NG * NPH + 4;

constexpr size_t MiB = 1u << 20;
constexpr size_t WS_CTL = 0, CTL_ZERO_BYTES = 128 * 1024;
constexpr size_t WS_MOD = 1 * MiB;
constexpr size_t WS_LB = WS_MOD + 33 * 6144 * 4;
constexpr size_t WS_WRT = WS_LB + 2 * 1024 * 4;
constexpr size_t WS_WSB = 2 * MiB;
constexpr size_t WS_VSTAT = 4 * MiB;
constexpr size_t WS_WIN = 12 * MiB;
constexpr size_t WS_WBA = 22 * MiB, WS_WBB = 23 * MiB, WS_WOUT = 24 * MiB;
constexpr size_t WS_W1 = 25 * MiB;
constexpr size_t WS_W2 = 89 * MiB;
constexpr size_t WS_H = 121 * MiB;
constexpr size_t WS_HC = 153 * MiB;
constexpr size_t WS_ZC = 161 * MiB;
constexpr size_t WS_Z = 209 * MiB;
constexpr size_t WS_YA = 785 * MiB, WS_YB = 817 * MiB;
constexpr size_t WS_MERGED = 849 * MiB;
constexpr size_t WS_OF = 881 * MiB, WS_OB = 945 * MiB;
constexpr size_t WS_END = 1009 * MiB;
constexpr int X1S = 2048;
constexpr size_t WS_H2 = 121 * MiB;
constexpr size_t WS_LIST = 185 * MiB;
constexpr size_t WS_TOPW = 193 * MiB;
constexpr size_t WS_SPOS = 194 * MiB;
constexpr size_t WS_ACT = 200 * MiB;
constexpr size_t WS_YSLOT = 464 * MiB;
static_assert(NG == 2 && MK_P2_FP8 && MK_P5_FP8 && MK_P6_FP8, "this workspace map is sized for two mixer groups and e4m3 operands");
static_assert(WS_WRT + 32 * 1024 * 4 <= WS_WSB && WS_ACT + ((size_t)TGM * 4 + 32 * 256) * 1024 <= WS_YSLOT && WS_YSLOT + ((size_t)TGM * 4 + 32 * 256) * 1024 * 2 <= WS_END, "ws map");
constexpr int CW_BAR = 4096;
constexpr int CW_CNT = 16384;

constexpr int RING_BYTES = 131072;
constexpr int LDS_BYTES = 147456;
constexpr int LDSCTL_OFF = 146432;
constexpr int LC_BAR = 0;
constexpr int LC_PT = 8;
constexpr int LC_CNT = 48;
constexpr int LC_LCNT = 80;
constexpr int LC_LBASE = 112;
constexpr int EXPT_BYTES_OFF = 141312;
constexpr int LC_EXPT = (EXPT_BYTES_OFF - LDSCTL_OFF) / 4;
static_assert(LDSCTL_OFF + 1024 == LDS_BYTES, "lds map");

__device__ __forceinline__ float bflo(unsigned w) { return __uint_as_float(w << 16); }
__device__ __forceinline__ float bfhi(unsigned w) { return __uint_as_float(w & 0xffff0000u); }
__device__ __forceinline__ float bf2f(bf16 b) { return __uint_as_float(((unsigned)b) << 16); }
typedef __bf16 bf16v2 __attribute__((ext_vector_type(2)));
__device__ __forceinline__ unsigned cvt_pk_bf16(float lo, float hi) { const f32x2 v = (f32x2){lo, hi}; const bf16v2 r = __builtin_convertvector(v, bf16v2); return __builtin_bit_cast(unsigned, r); }
typedef int i32x8 __attribute__((ext_vector_type(8)));
typedef int i32x4 __attribute__((ext_vector_type(4)));
__device__ __forceinline__ unsigned pack4_fp8(float a, float b, float c, float d) {
    a = __builtin_fminf(__builtin_fmaxf(a, -448.f), 448.f); b = __builtin_fminf(__builtin_fmaxf(b, -448.f), 448.f); c = __builtin_fminf(__builtin_fmaxf(c, -448.f), 448.f); d = __builtin_fminf(__builtin_fmaxf(d, -448.f), 448.f);
    int p = __builtin_amdgcn_cvt_pk_fp8_f32(a, b, 0, false); p = __builtin_amdgcn_cvt_pk_fp8_f32(c, d, p, true); return (unsigned)p; }
constexpr float W8_SCALE = 32.0f, W8_INV = 1.0f / 32.0f;
__device__ __forceinline__ float fexp(float x) { return __builtin_amdgcn_exp2f(x * 1.44269504089f); }
__device__ __forceinline__ float flog(float x) { return __builtin_amdgcn_logf(x) * 0.69314718056f; }
__device__ __forceinline__ float frsq(float x) { return __builtin_amdgcn_rsqf(x); }
__device__ __forceinline__ float frcp(float x) { return __builtin_amdgcn_rcpf(x); }
__device__ __forceinline__ float fsigmoid(float x) { return frcp(1.0f + fexp(-x)); }
#define SWZ_XOR(x, k) __int_as_float(__builtin_amdgcn_ds_swizzle(__float_as_int(x), ((k) << 10) | 0x1F))
__device__ __forceinline__ float add_xor32(float v) { const auto r = __builtin_amdgcn_permlane32_swap(__float_as_uint(v), __float_as_uint(v), false, false); return __uint_as_float(r[0]) + __uint_as_float(r[1]); }
__device__ __forceinline__ float wave_sum(float v) {
    v += SWZ_XOR(v, 1); v += SWZ_XOR(v, 2); v += SWZ_XOR(v, 4); v += SWZ_XOR(v, 8); v += SWZ_XOR(v, 16);
    return __int_as_float(__builtin_amdgcn_readlane(__float_as_int(v), 0)) + __int_as_float(__builtin_amdgcn_readlane(__float_as_int(v), 32));
}
__device__ __forceinline__ int lane_now() { int l; asm volatile("v_mbcnt_lo_u32_b32 %0, -1, 0\n\tv_mbcnt_hi_u32_b32 %0, -1, %0" : "=v"(l)); return l; }
__device__ __forceinline__ int launder(int v) { asm volatile("" : "+v"(v)); return v; }
#define LDS_WAIT() asm volatile("s_waitcnt lgkmcnt(0)" ::: "memory")
#define LDSBAR() do { asm volatile("s_waitcnt lgkmcnt(0)" ::: "memory"); __builtin_amdgcn_s_barrier(); asm volatile("" ::: "memory"); } while (0)
#define VM_WAIT() asm volatile("s_waitcnt vmcnt(0)" ::: "memory")
__device__ __forceinline__ f32x2 gelu_pk(f32x2 v) {
    const f32x2 av = __builtin_elementwise_abs(v), d = av * 0.2316418882f + 1.0f;
    f32x2 t; t.x = __builtin_amdgcn_rcpf(d.x); t.y = __builtin_amdgcn_rcpf(d.y);
    f32x2 q = t * 0.5307027145f + (-0.7265760135f); q = q * t + 0.7107068705f; q = q * t + (-0.142248368f); q = q * t + 0.127414796f; q = q * t;
    const f32x2 s = (v * v) * (-0.72134752044f);
    f32x2 e; e.x = __builtin_amdgcn_exp2f(s.x); e.y = __builtin_amdgcn_exp2f(s.y);
    const f32x2 m = v * (q * e), r = v - m;
    f32x2 o; o.x = v.x < 0.f ? m.x : r.x; o.y = v.y < 0.f ? m.y : r.y; return o;
}

namespace pg8 {
constexpr int BM = 256, BK = 64, HALF = 128, HTB = HALF * BK * 2, STAGE_BYTES = 8 * HTB, BIAS_OFF = STAGE_BYTES + 8192;
__device__ __forceinline__ int lds_byte(int r, int c) { const int st = (r >> 4) * 2 + (c >> 5), rr = r & 15, cc = c & 31, ob = rr * 64 + cc * 2; return st * 1024 + (ob ^ (((ob >> 9) & 1) << 5)); }
__device__ __forceinline__ void stage_rc(int b, int& R, int& C) { const int st = b / 1024, sb = b % 1024, swz = sb ^ (((sb >> 9) & 1) << 5); R = (st >> 1) * 16 + swz / 64; C = (st & 1) * 32 + (swz % 64) / 2; }
__device__ __forceinline__ int perm32(int rho) { const int n = rho >> 4, i = rho & 15; return 8 * (i >> 2) + 4 * n + (i & 3); }

struct Unit { unsigned A, B0, B1; int r0, c0, aux, aux2, aux3; };
template <int nM, int nN> __device__ __forceinline__ void map_tile(int L, int& pm, int& pn) {
    constexpr int nwg = nM * nN; int wgid = L;
    { constexpr int q = nwg / 8, r = nwg % 8; const int xcd = wgid % 8, off = wgid / 8; wgid = (xcd < r ? xcd * (q + 1) : r * (q + 1) + (xcd - r) * q) + off; }
    static_assert(nM % 8 == 0, "row tiles come in groups of 8");
    constexpr int nig = 8 * nN; const int gid = wgid / nig, fm = gid * 8; constexpr int gsz = 8;
    pm = fm + ((wgid % nig) % gsz); pn = (wgid % nig) / gsz;
}

template <class Epi, class Sched, bool GATHER, bool F8 = false, bool ASMMMA = false>
__device__ __forceinline__ void gemm_phase(LAS unsigned char* lds, const __amdgpu_buffer_rsrc_t rsrc, const int tid_in, const int K, const Sched& S, const Epi& E) {
    const int tid = tid_in, wid = __builtin_amdgcn_readfirstlane(tid >> 6), lane = tid & 63, wr = wid >> 2, wc = wid & 3, fr = lane & 15, fq = lane >> 4;
    const int nt = F8 ? K / 128 : K / BK; const int rowpitch = F8 ? K : 2 * K;
    unsigned voffB[2], vA[2][2];
#pragma unroll
    for (int i = 0; i < 2; ++i) { int R, C; stage_rc(tid * 16 + i * 8192, R, C); const int Rb = Epi::PERM ? ((R & ~31) + perm32(R & 31)) : R;
        voffB[i] = (unsigned)(Rb * rowpitch + 2 * C);
        vA[0][i] = (unsigned)(R * rowpitch + 2 * C); vA[1][i] = vA[0][i]; }
    const unsigned hA = GATHER ? 0u : (unsigned)(HALF * rowpitch);
    const unsigned kstep = (unsigned)(BK * 2);
    const unsigned ldsw = (unsigned)wid * 1024u;
    const int f8o = (fq >> 1) * 1024 + fr * 64 + 32 * ((fq & 1) ^ (fr >> 3));
    const int aoff = F8 ? (wr * 4) * 2048 + f8o : lds_byte(wr * 64 + fr, fq * 8), boff = F8 ? (wc * 2) * 2048 + f8o : lds_byte(wc * 32 + fr, fq * 8);
    constexpr int KOFF = F8 ? 16 : 1024;
#define PG8_SA(b, h) (((b) * 2 + (h)) * HTB)
#define PG8_SB(b, h) ((4 + (b) * 2 + (h)) * HTB)
#define PG8_STAGE(bufoff, gbase, voff) do { _Pragma("unroll") for (int _i = 0; _i < 2; ++_i) \
        __builtin_amdgcn_raw_ptr_buffer_load_lds(rsrc, (LAS void*)(lds + (bufoff) + ldsw + _i * 8192), 16, (int)(voff)[_i], (int)(gbase), 0, 0); } while (0)
#define PG8_LDA(dst, b, h) do { _Pragma("unroll") for (int m = 0; m < 4; ++m) _Pragma("unroll") for (int k = 0; k < 2; ++k) dst[m][k] = *(const LAS bf16x8*)(lds + PG8_SA(b, h) + aoff + m * 2048 + k * KOFF); } while (0)
#define PG8_LDB(dst, b, h) do { _Pragma("unroll") for (int n = 0; n < 2; ++n) _Pragma("unroll") for (int k = 0; k < 2; ++k) dst[n][k] = *(const LAS bf16x8*)(lds + PG8_SB(b, h) + boff + n * 2048 + k * KOFF); } while (0)
#define PG8_CAT(lo, hi) __builtin_shufflevector(__builtin_bit_cast(i32x4, lo), __builtin_bit_cast(i32x4, hi), 0, 1, 2, 3, 4, 5, 6, 7)
#define PG8_MMA(ai, bj, At, Bt) do { __builtin_amdgcn_s_setprio(1); _Pragma("unroll") for (int m = 0; m < 4; ++m) _Pragma("unroll") for (int n = 0; n < 2; ++n) { \
        if constexpr (F8 && !ASMMMA) acc[ai][bj][m][n] = __builtin_amdgcn_mfma_scale_f32_16x16x128_f8f6f4(PG8_CAT(Bt[n][0], Bt[n][1]), PG8_CAT(At[m][0], At[m][1]), acc[ai][bj][m][n], 0, 0, 0, 0, 0, 0); \
        else if constexpr (F8) { const i32x8 b8_ = PG8_CAT(Bt[n][0], Bt[n][1]), a8_ = PG8_CAT(At[m][0], At[m][1]); \
            asm volatile("v_mfma_f32_16x16x128_f8f6f4 %0, %1, %2, %0" : "+v"(acc[ai][bj][m][n]) : "v"(b8_), "v"(a8_)); } \
        else { _Pragma("unroll") for (int k = 0; k < 2; ++k) acc[ai][bj][m][n] = __builtin_amdgcn_mfma_f32_16x16x32_bf16(Bt[n][k], At[m][k], acc[ai][bj][m][n], 0, 0, 0); } } \
        __builtin_amdgcn_s_setprio(0); } while (0)
#define PG8_WAIT_V(n) asm volatile("s_waitcnt vmcnt(" #n ")" ::: "memory")
#define PG8_WAIT_L(n) asm volatile("s_waitcnt lgkmcnt(" #n ")" ::: "memory")
#define PG8_BAR __builtin_amdgcn_s_barrier()
#define PG8_SCHED __builtin_amdgcn_sched_barrier(0)
    Unit cur, nxt; int ui = 0;
    if (!S.next(0, cur)) return;
    if constexpr (GATHER) S.a_offsets(cur, wid, vA);
    f32x4 acc[2][2][4][2];
#pragma unroll
    for (int a = 0; a < 2; ++a)
#pragma unroll
        for (int b = 0; b < 2; ++b)
#pragma unroll
            for (int m = 0; m < 4; ++m)
#pragma unroll
                for (int n = 0; n < 2; ++n) { acc[a][b][m][n] = (f32x4){0.f, 0.f, 0.f, 0.f}; if constexpr (F8) asm volatile("" : "+v"(acc[a][b][m][n])); }
    bf16x8 At[4][2], B0[2][2], B1[2][2];
    unsigned cA = cur.A, cB0 = cur.B0, cB1 = cur.B1;
    PG8_STAGE(PG8_SB(0, 0), cB0, voffB); PG8_STAGE(PG8_SB(0, 1), cB1, voffB); PG8_STAGE(PG8_SA(0, 0), cA, vA[0]); PG8_STAGE(PG8_SA(0, 1), cA + hA, vA[1]);
    if (wr == 1) PG8_BAR;
    PG8_WAIT_V(2); PG8_BAR;
    PG8_STAGE(PG8_SB(1, 0), cB0 + kstep, voffB); PG8_STAGE(PG8_SA(1, 0), cA + kstep, vA[0]); PG8_STAGE(PG8_SB(1, 1), cB1 + kstep, voffB);
    PG8_WAIT_V(6); PG8_BAR;
    for (;;) {
        const bool has_next = S.next(ui + 1, nxt);
        if constexpr (GATHER) { if (has_next) { unsigned nv[2][2]; S.a_offsets(nxt, wid, nv); *(LAS u32x4*)(lds + STAGE_BYTES + tid * 16) = (u32x4){nv[0][0], nv[0][1], nv[1][0], nv[1][1]}; } }
        const unsigned nA = has_next ? nxt.A : cA, nB0 = has_next ? nxt.B0 : cB0, nB1 = has_next ? nxt.B1 : cB1;
        if constexpr (Epi::BIAS) { if (wid == 0) E.bias_dma(lds + BIAS_OFF + (ui & 1) * 1024, cur); }
#pragma unroll 1
        for (int t = 0; t < nt; t += 2) {
            const bool last = (t == nt - 2);
            const unsigned a1 = cA + (unsigned)(t + 1) * kstep;
            const unsigned a2 = last ? nA : cA + (unsigned)(t + 2) * kstep;
            const unsigned b20 = last ? nB0 : cB0 + (unsigned)(t + 2) * kstep, b21 = last ? nB1 : cB1 + (unsigned)(t + 2) * kstep;
            const unsigned a3 = a2 + kstep, b30 = b20 + kstep, b31 = b21 + kstep;
            PG8_LDB(B0, 0, 0); PG8_LDB(B1, 0, 1); PG8_SCHED; PG8_LDA(At, 0, 0); PG8_STAGE(PG8_SA(1, 1), a1 + hA, vA[1]);
            if constexpr (GATHER) { if (last && has_next) { const u32x4 nv = *(const LAS u32x4*)(lds + STAGE_BYTES + tid * 16); vA[0][0] = nv.x; vA[0][1] = nv.y; vA[1][0] = nv.z; vA[1][1] = nv.w; } }
            PG8_WAIT_V(8); PG8_WAIT_L(0); PG8_BAR; PG8_MMA(0, 0, At, B0); PG8_MMA(0, 1, At, B1); PG8_BAR; PG8_SCHED;
            PG8_LDA(At, 0, 1); PG8_STAGE(PG8_SB(0, 0), b20, voffB); PG8_STAGE(PG8_SB(0, 1), b21, voffB); PG8_STAGE(PG8_SA(0, 0), a2, vA[0]);
            PG8_WAIT_V(8); PG8_WAIT_L(0); PG8_BAR; PG8_MMA(1, 0, At, B0); PG8_MMA(1, 1, At, B1); PG8_BAR; PG8_SCHED;
            PG8_LDB(B0, 1, 0); PG8_LDB(B1, 1, 1); PG8_SCHED; PG8_LDA(At, 1, 0); PG8_STAGE(PG8_SA(0, 1), a2 + hA, vA[1]);
            PG8_WAIT_V(8); PG8_WAIT_L(0); PG8_BAR; PG8_MMA(0, 0, At, B0); PG8_MMA(0, 1, At, B1); PG8_BAR; PG8_SCHED;
            PG8_LDA(At, 1, 1); PG8_STAGE(PG8_SB(1, 0), b30, voffB); PG8_STAGE(PG8_SB(1, 1), b31, voffB); PG8_STAGE(PG8_SA(1, 0), a3, vA[0]);
            PG8_WAIT_V(8); PG8_WAIT_L(0); PG8_BAR; PG8_MMA(1, 0, At, B0); PG8_MMA(1, 1, At, B1); PG8_BAR; PG8_SCHED;
        }
        if (wr == 0) PG8_BAR;
        if constexpr (F8 && ASMMMA) asm volatile("s_nop 15\n\ts_nop 15" ::: "memory");
        { const int le = lane_now(); if constexpr (Epi::BIAS) E(acc, cur, wr, wc, le & 15, le >> 4, lds + BIAS_OFF + (ui & 1) * 1024); else E(acc, cur, wr, wc, le & 15, le >> 4); }
        if (!has_next) break;
#pragma unroll
        for (int a = 0; a < 2; ++a)
#pragma unroll
            for (int b = 0; b < 2; ++b)
#pragma unroll
                for (int m = 0; m < 4; ++m)
#pragma unroll
                    for (int n = 0; n < 2; ++n) { acc[a][b][m][n] = (f32x4){0.f, 0.f, 0.f, 0.f}; if constexpr (F8) asm volatile("" : "+v"(acc[a][b][m][n])); }
        cur = nxt; cA = nA; cB0 = nB0; cB1 = nB1; ++ui;
        if (wr == 1) PG8_BAR;
    }
    PG8_WAIT_V(0);
    PG8_BAR;
#undef PG8_SA
#undef PG8_SB
#undef PG8_STAGE
#undef PG8_LDA
#undef PG8_LDB
#undef PG8_MMA
#undef PG8_CAT
#undef PG8_WAIT_V
#undef PG8_WAIT_L
#undef PG8_BAR
#undef PG8_SCHED
}
}

#define XB_TMO      128
#define XB_XCNT(j)  (256  + 64 * (j))
#define XB_XSUB(j)  (1280 + 64 * (j))
#define XB_XGEN(j)  (2304 + 64 * (j))
#define XB_TOP      3328
#define XB_TOPGEN   3392
#define XCD_BAR_WORDS 3456
#define XB_SPIN_CAP (1u << 18)
__device__ __forceinline__ unsigned xb_ld(unsigned* p)              { return __hip_atomic_load(p, __ATOMIC_RELAXED, __HIP_MEMORY_SCOPE_AGENT); }
__device__ __forceinline__ unsigned xb_add(unsigned* p, unsigned v) { return __hip_atomic_fetch_add(p, v, __ATOMIC_RELAXED, __HIP_MEMORY_SCOPE_AGENT); }
__device__ __forceinline__ unsigned xb_xcc_id() { return (unsigned)__builtin_amdgcn_s_getreg((3 << 11) | 20) & 0xFu; }
#define XB_SPIN(cond, bar) do { unsigned _sp = 0; while (cond) { __builtin_amdgcn_s_sleep(1); \
    if ((++_sp & 255u) == 0u) { if (xb_ld(&(bar)[XB_TMO])) break; if (_sp > XB_SPIN_CAP) { atomicAdd(&(bar)[XB_TMO], 1u); break; } } } } while (0)
struct XcdBarrier { unsigned* bar; unsigned x; volatile LAS unsigned* st; int wave; };
__device__ __forceinline__ bool xb_thread0(int wave) { return wave == 0 && lane_now() == 0; }
__device__ __forceinline__ XcdBarrier xcd_barrier_post(unsigned* bar, volatile LAS unsigned* st, int wave) {
    XcdBarrier b; b.bar = bar; b.x = xb_xcc_id(); b.st = st; b.wave = wave;
    if (xb_thread0(wave)) (void)xb_add(&bar[XB_XCNT(b.x)], 1u);
    return b;
}
__device__ __forceinline__ void xcd_barrier_complete(unsigned* bar, unsigned x, unsigned& nloc, unsigned& nx) {
    const unsigned G = gridDim.x * gridDim.y * gridDim.z;
    unsigned sum, cnt, mine, sp = 0u;
    for (;;) {
        sum = 0u; cnt = 0u; mine = 0u;
#pragma unroll
        for (unsigned j = 0; j < 16; ++j) { const unsigned c = xb_ld(&bar[XB_XCNT(j)]); sum += c; cnt += (c > 0u) ? 1u : 0u; mine = (j == x) ? c : mine; }
        if (sum == G) break;
        __builtin_amdgcn_s_sleep(1);
        if ((++sp & 255u) == 0u) { if (xb_ld(&bar[XB_TMO])) break; if (sp > XB_SPIN_CAP) { atomicAdd(&bar[XB_TMO], 1u); break; } }
    }
    nloc = mine > 0u ? mine : 1u; nx = cnt > 0u ? cnt : 1u;
}
__device__ __forceinline__ void xcd_barrier(const XcdBarrier& b) {
    asm volatile("s_waitcnt vmcnt(0)" ::: "memory");
    __syncthreads();
    if (xb_thread0(b.wave)) {
        unsigned* bar = b.bar;
        __builtin_amdgcn_s_waitcnt(0);
        unsigned nloc = b.st[0], nx = b.st[1];
        if (nloc == 0u) { xcd_barrier_complete(bar, b.x, nloc, nx); b.st[0] = nloc; b.st[1] = nx; }
        const unsigned old = xb_add(&bar[XB_XSUB(b.x)], 1u);
        const unsigned gen = old / nloc;
        if (old + 1u == (gen + 1u) * nloc) {
            __builtin_amdgcn_fence(__ATOMIC_RELEASE, "agent");
            asm volatile("s_waitcnt vmcnt(0)" ::: "memory");
            const unsigned og = xb_add(&bar[XB_TOP], 1u);
            const unsigned tg = og / nx;
            if (og + 1u == (tg + 1u) * nx) xb_add(&bar[XB_TOPGEN], 1u);
            else XB_SPIN(xb_ld(&bar[XB_TOPGEN]) == tg, bar);
            __builtin_amdgcn_fence(__ATOMIC_ACQUIRE, "agent");
            xb_add(&bar[XB_XGEN(b.x)], 1u);
            asm volatile("s_waitcnt vmcnt(0)" ::: "memory");
        } else {
            XB_SPIN(xb_ld(&bar[XB_XGEN(b.x)]) == gen, bar);
            __builtin_amdgcn_fence(__ATOMIC_ACQUIRE, "agent");
            asm volatile("s_waitcnt vmcnt(0)" ::: "memory");
        }
    }
    __syncthreads();
}

struct Args { const float* in[24]; float* out; unsigned char* ws; int pid_lo, pid_hi, dry, pad; };
struct Frame {
    LAS unsigned char* lds; volatile LAS unsigned* LC; gu32* ctl;
    int tid, lane, wave, G, blk;
    GAS float* out; GAS unsigned char* ws;
};
typedef const Args __attribute__((address_space(4))) CArgs;
__device__ __forceinline__ CArgs* argp() { CArgs* p = (CArgs*)__builtin_amdgcn_kernarg_segment_ptr(); asm volatile("" : "+s"(p)); return p; }
#define INP(i) (ap->in[i])
#define WSP(type, off) ((type*)(GAS type*)(F.ws + (off)))
#define X1P(r) ((bf16*)(GAS bf16*)((GAS unsigned char*)F.out + (size_t)(r) * 4096 + 2048))

__device__ __forceinline__ void p0_transpose_item(const float* W, int K, int N, bf16* WT, LAS float* scr, int item, int lane) {
    const int nblk = N / 32, kb = item / nblk, nb = item % nblk, k0 = 64 * kb, n0 = 32 * nb;
#pragma unroll 8
    for (int i = 0; i < 32; ++i) { const int kk = 2 * i + (lane >> 5); scr[kk * 33 + (lane & 31)] = W[(size_t)(k0 + kk) * N + n0 + (lane & 31)]; }
    LDS_WAIT(); asm volatile("" ::: "memory");
    const int c = lane & 7;
#pragma unroll
    for (int j = 0; j < 4; ++j) { const int n = (lane >> 3) + 8 * j; const LAS float* s = scr + (8 * c) * 33 + n;
        u32x4 o; o.x = cvt_pk_bf16(s[0 * 33], s[1 * 33]); o.y = cvt_pk_bf16(s[2 * 33], s[3 * 33]); o.z = cvt_pk_bf16(s[4 * 33], s[5 * 33]); o.w = cvt_pk_bf16(s[6 * 33], s[7 * 33]);
        *(u32x4*)(WT + (size_t)(n0 + n) * K + k0 + 8 * c) = o; }
    LDS_WAIT(); asm volatile("" ::: "memory");
}
__device__ __forceinline__ void p0_transpose_item8(const float* W, int K, int N, unsigned char* WT, LAS float* scr, int item, int lane, float scale) {
    const int nblk = N / 32, kb = item / nblk, nb = item % nblk, k0 = 64 * kb, n0 = 32 * nb;
#pragma unroll 8
    for (int i = 0; i < 32; ++i) { const int kk = 2 * i + (lane >> 5); scr[kk * 33 + (lane & 31)] = W[(size_t)(k0 + kk) * N + n0 + (lane & 31)]; }
    LDS_WAIT(); asm volatile("" ::: "memory");
    const int c = lane & 7;
#pragma unroll
    for (int j = 0; j < 4; ++j) { const int n = (lane >> 3) + 8 * j; const LAS float* p = scr + (8 * c) * 33 + n;
        u32x2 o; o.x = pack4_fp8(p[0 * 33] * scale, p[1 * 33] * scale, p[2 * 33] * scale, p[3 * 33] * scale); o.y = pack4_fp8(p[4 * 33] * scale, p[5 * 33] * scale, p[6 * 33] * scale, p[7 * 33] * scale);
        *(u32x2*)(WT + (size_t)(n0 + n) * K + k0 + 8 * c) = o; }
    LDS_WAIT(); asm volatile("" ::: "memory");
}
struct P0Item { const float* W; unsigned char* WT; int K, N, item; };
__device__ __forceinline__ void p0_item_load(const P0Item& t, int lane, f32x4 (&buf)[16]) {
    const int nblk = t.N / 64, kb = t.item / nblk, nb = t.item % nblk, k0 = 64 * kb, n0 = 64 * nb;
    const float* p = t.W + (size_t)(k0 + (lane >> 4)) * t.N + n0 + 4 * (lane & 15);
#pragma unroll
    for (int i = 0; i < 16; ++i) buf[i] = *(const f32x4*)(p + (size_t)(4 * i) * t.N);
}
__device__ __forceinline__ void p0_item_to_lds(LAS float* scr, int lane, const f32x4 (&buf)[16]) {
#pragma unroll
    for (int i = 0; i < 16; ++i) { LAS float* q = scr + (4 * i + (lane >> 4)) * 65 + 4 * (lane & 15); q[0] = buf[i].x; q[1] = buf[i].y; q[2] = buf[i].z; q[3] = buf[i].w; }
}
__device__ __forceinline__ void p0_item_finish(const P0Item& t, LAS float* scr, int lane, float scale) {
    const int nblk = t.N / 64, kb = t.item / nblk, nb = t.item % nblk, k0 = 64 * kb, n0 = 64 * nb;
    const int c = lane & 7;
#pragma unroll
    for (int j = 0; j < 8; ++j) { const int n = (lane >> 3) + 8 * j; const LAS float* p = scr + (8 * c) * 65 + n;
        u32x2 o; o.x = pack4_fp8(p[0 * 65] * scale, p[1 * 65] * scale, p[2 * 65] * scale, p[3 * 65] * scale); o.y = pack4_fp8(p[4 * 65] * scale, p[5 * 65] * scale, p[6 * 65] * scale, p[7 * 65] * scale);
        *(u32x2*)(t.WT + (size_t)(n0 + n) * t.K + k0 + 8 * c) = o; }
}
__device__ __forceinline__ void p0_prologue(Frame& F) {
    CArgs* ap = argp();
    float* mod = WSP(float, WS_MOD);
    if (F.blk < 96) {
        LAS float* S = (LAS float*)F.lds;
        { f32x4 cv[17];
#pragma unroll
          for (int i = 0; i < 17; ++i) { const int vi = F.tid + 512 * i; cv[i] = (vi < 8192) ? ((const f32x4*)INP(1))[vi] : ((const f32x4*)INP(3))[vi < 8448 ? vi - 8192 : 0]; }
          asm volatile("" ::: "memory");
#pragma unroll
          for (int i = 0; i < 17; ++i) { const int vi = F.tid + 512 * i; const f32x4 v = cv[i];
              if (vi < 8448) *(LAS f32x4*)(S + 4 * vi) = (f32x4){v.x * fsigmoid(v.x), v.y * fsigmoid(v.y), v.z * fsigmoid(v.z), v.w * fsigmoid(v.w)}; } }
        __syncthreads();
        const int n0 = F.blk * 64, col = n0 + F.lane; const float* wmod = INP(6);
        float acc[33];
#pragma unroll
        for (int r = 0; r < 33; ++r) acc[r] = 0.f;
        for (int k = 128 * F.wave; k < 128 * F.wave + 128; k += 8) {
            const float w0 = wmod[(size_t)(k + 0) * 6144 + col], w1 = wmod[(size_t)(k + 1) * 6144 + col], w2 = wmod[(size_t)(k + 2) * 6144 + col], w3 = wmod[(size_t)(k + 3) * 6144 + col];
            const float w4 = wmod[(size_t)(k + 4) * 6144 + col], w5 = wmod[(size_t)(k + 5) * 6144 + col], w6 = wmod[(size_t)(k + 6) * 6144 + col], w7 = wmod[(size_t)(k + 7) * 6144 + col];
            asm volatile("" ::: "memory");
#pragma unroll
            for (int r = 0; r < 33; ++r) { const f32x4 s = *(const LAS f32x4*)(S + r * 1024 + k), t = *(const LAS f32x4*)(S + r * 1024 + k + 4);
                acc[r] += (s.x * w0 + s.y * w1 + s.z * w2 + s.w * w3) + (t.x * w4 + t.y * w5 + t.z * w6 + t.w * w7); }
        }
        __syncthreads();
        LAS float* RED = (LAS float*)F.lds;
#pragma unroll
        for (int r = 0; r < 33; ++r) RED[(F.wave * 33 + r) * 64 + F.lane] = acc[r];
        __syncthreads();
        for (int idx = F.tid; idx < 33 * 64; idx += 512) { const int r = idx >> 6, l = idx & 63; float s = INP(7)[n0 + l];
#pragma unroll
            for (int w = 0; w < 8; ++w) s += RED[(w * 33 + r) * 64 + l];
            mod[r * 6144 + n0 + l] = s; }
        __syncthreads();
    }
    if (F.blk == 96) {
        float* lb = WSP(float, WS_LB);
        for (int j = F.tid; j < 1024; j += 512) { lb[j] = frcp(1.0f + fexp(INP(9)[1024 + j] - INP(9)[j])); lb[1024 + j] = frcp(1.0f + fexp(INP(10)[1024 + j] - INP(10)[j])); }
    }
    if (F.blk == 97) { bf16* whi = WSP(bf16, WS_WRT); bf16* wlo = whi + 32 * 1024; for (int idx = F.tid; idx < 32 * 1024; idx += 512) { const int e = idx >> 10, cc = idx & 1023; const float v = INP(17)[cc * 32 + e];
            const unsigned h = cvt_pk_bf16(v, 0.f) & 0xffffu; whi[idx] = (bf16)h; wlo[idx] = (bf16)(cvt_pk_bf16(v - bflo(h), 0.f) & 0xffffu); } }
    if (F.blk >= 98 && F.blk < 106) { bf16* wsb = WSP(bf16, WS_WSB); const int g = F.blk - 98; for (int idx = F.tid * 2; idx < 128 * 128; idx += 1024) { const float a = INP(12)[g * 16384 + idx], b = INP(12)[g * 16384 + idx + 1]; *(unsigned*)(wsb + g * 16384 + idx) = cvt_pk_bf16(a, b); } }
    LAS float* scr = (LAS float*)(F.lds + F.wave * 16384);
    const int gw = F.blk * 8 + F.wave, NGW = F.G * 8;
    constexpr int I_IN = 16 * (INW / 32), I_SQ = 16 * 32, I_W1 = 16 * 64, I_W2 = 16 * 32;
    constexpr int NITEMS = I_IN + 3 * I_SQ + NE * I_W1 + NE * I_W2;
    if (MK_P2_FP8 && MK_P5_FP8 && MK_P6_FP8) {
        constexpr int I_IN = 16 * (INW / 64), I_SQ = 16 * 16, I_W1 = 16 * 32, I_W2 = 16 * 16, NITEMS = I_IN + 3 * I_SQ + NE * I_W1 + NE * I_W2;
        LAS float* scr = (LAS float*)(F.lds + F.wave * 16896);
        auto decode = [&](int it) -> P0Item {
            int r = it;
            if (r < I_IN) return P0Item{INP(8), WSP(unsigned char, WS_WIN), D, INW, r}; r -= I_IN;
            if (r < I_SQ) return P0Item{INP(14), WSP(unsigned char, WS_WBA), D, D, r}; r -= I_SQ;
            if (r < I_SQ) return P0Item{INP(15), WSP(unsigned char, WS_WBB), D, D, r}; r -= I_SQ;
            if (r < I_SQ) return P0Item{INP(16), WSP(unsigned char, WS_WOUT), D, D, r}; r -= I_SQ;
            if (r < NE * I_W1) { const int e = r / I_W1; return P0Item{INP(19) + (size_t)e * D * 2 * FE, WSP(unsigned char, WS_W1) + (size_t)e * 2 * FE * D, D, 2 * FE, r % I_W1}; } r -= NE * I_W1;
            const int e = r / I_W2; return P0Item{INP(21) + (size_t)e * FE * D, WSP(unsigned char, WS_W2) + (size_t)e * D * FE, FE, D, r % I_W2}; };
        constexpr int P0_TAIL = (NITEMS * MK_P0_TAIL_PCT / 100) & ~7, NCOMMON = NITEMS - P0_TAIL;
        const int gw2 = (F.blk - 96) * 8 + F.wave, NGW2 = (F.G - 96) * 8;
        f32x4 buf[16];
        int it = gw;
        P0Item cur = decode(it < NITEMS ? it : 0);
        if (it < NITEMS) p0_item_load(cur, F.lane, buf);
        while (it < NITEMS) {
            p0_item_to_lds(scr, F.lane, buf);
            int nit = it + (it < NCOMMON ? NGW : NGW2);
            if (it < NCOMMON && nit >= NCOMMON) nit = (F.blk >= 96) ? NCOMMON + gw2 : NITEMS;
            P0Item nxt = cur;
            if (nit < NITEMS) { nxt = decode(nit); p0_item_load(nxt, F.lane, buf); }
            LDS_WAIT(); asm volatile("" ::: "memory");
            p0_item_finish(cur, scr, F.lane, W8_SCALE);
            LDS_WAIT(); asm volatile("" ::: "memory");
            cur = nxt; it = nit;
        }
    } else
    for (int it = gw; it < NITEMS; it += NGW) {
        int r = it;
        if (r < I_IN) { if (MK_P2_FP8) p0_transpose_item8(INP(8), D, INW, WSP(unsigned char, WS_WIN), scr, r, F.lane, W8_SCALE); else p0_transpose_item(INP(8), D, INW, WSP(bf16, WS_WIN), scr, r, F.lane); continue; } r -= I_IN;
        if (r < I_SQ) { if (MK_P5_FP8) p0_transpose_item8(INP(14), D, D, WSP(unsigned char, WS_WBA), scr, r, F.lane, W8_SCALE); else p0_transpose_item(INP(14), D, D, WSP(bf16, WS_WBA), scr, r, F.lane); continue; } r -= I_SQ;
        if (r < I_SQ) { if (MK_P5_FP8) p0_transpose_item8(INP(15), D, D, WSP(unsigned char, WS_WBB), scr, r, F.lane, W8_SCALE); else p0_transpose_item(INP(15), D, D, WSP(bf16, WS_WBB), scr, r, F.lane); continue; } r -= I_SQ;
        if (r < I_SQ) { if (MK_P6_FP8) p0_transpose_item8(INP(16), D, D, WSP(unsigned char, WS_WOUT), scr, r, F.lane, W8_SCALE); else p0_transpose_item(INP(16), D, D, WSP(bf16, WS_WOUT), scr, r, F.lane); continue; } r -= I_SQ;
        if (r < NE * I_W1) { const int e = r / I_W1; p0_transpose_item8(INP(19) + (size_t)e * D * 2 * FE, D, 2 * FE, WSP(unsigned char, WS_W1) + (size_t)e * 2 * FE * D, scr, r % I_W1, F.lane, W8_SCALE); continue; } r -= NE * I_W1;
        { const int e = r / I_W2; p0_transpose_item8(INP(21) + (size_t)e * FE * D, FE, D, WSP(unsigned char, WS_W2) + (size_t)e * D * FE, scr, r % I_W2, F.lane, W8_SCALE); }
    }
}

__device__ __forceinline__ void p1_rows(Frame& F, int grp) {
    CArgs* ap = argp(); const float* xin = INP(0); const float* ctxin = INP(2); const float* n1g = INP(4);
    const float* mod = WSP(float, WS_MOD);
    constexpr int ESZ = MK_P2_FP8 ? 1 : 2;
    const int gw = F.blk * 8 + F.wave, NGW = F.G * 8;
    for (int part = 0; part < (grp == 0 ? 2 : 1); ++part) {
        const int wps = part ? NGW : NGW / GB, seq = part ? 0 : gw / wps, wq = part ? gw : gw % wps;
        const int r0 = (part ? 0 : seq * T) + wq, r1 = part ? NCTX : ((seq < GB) ? (seq + 1) * T : 0), rstep = wps;
        f32x4 ma[4], mb[4]; int curb = -1;
        for (int r = r0; r < r1; r += 2 * rstep) {
            const int bsel = part ? 32 : grp * GB + (r >> 11);
            if (bsel != curb) { const float* mrow = mod + (size_t)bsel * 6144; curb = bsel;
#pragma unroll
                for (int j = 0; j < 4; ++j) { ma[j] = ((const f32x4*)n1g)[F.lane + 64 * j] * (((const f32x4*)(mrow + 1024))[F.lane + 64 * j] + 1.0f); mb[j] = ((const f32x4*)mrow)[F.lane + 64 * j]; } }
            const int rB = (r + rstep < r1) ? r + rstep : r;
            const float* srcA = part ? ctxin + (size_t)r * D : xin + ((size_t)grp * TG + r) * D; const float* srcB = part ? ctxin + (size_t)rB * D : xin + ((size_t)grp * TG + rB) * D;
            unsigned char* dbase = part ? WSP(unsigned char, WS_HC) : WSP(unsigned char, WS_H);
            f32x4 va[4], vb[4]; float sa = 0.f, sb = 0.f;
#pragma unroll
            for (int j = 0; j < 4; ++j) { va[j] = __builtin_nontemporal_load((const f32x4*)srcA + F.lane + 64 * j); vb[j] = __builtin_nontemporal_load((const f32x4*)srcB + F.lane + 64 * j); }
#pragma unroll
            for (int j = 0; j < 4; ++j) { sa += (va[j].x * va[j].x + va[j].y * va[j].y) + (va[j].z * va[j].z + va[j].w * va[j].w); sb += (vb[j].x * vb[j].x + vb[j].y * vb[j].y) + (vb[j].z * vb[j].z + vb[j].w * vb[j].w); }
            const float rsa = frsq(wave_sum(sa) * (1.0f / D) + EPS), rsb = frsq(wave_sum(sb) * (1.0f / D) + EPS);
#pragma unroll
            for (int j = 0; j < 4; ++j) {
                const f32x4 ha = va[j] * rsa * ma[j] + mb[j], hb = vb[j] * rsb * ma[j] + mb[j];
                if (MK_P2_FP8) { ((unsigned*)(dbase + (size_t)r * D * ESZ))[F.lane + 64 * j] = pack4_fp8(ha.x, ha.y, ha.z, ha.w); ((unsigned*)(dbase + (size_t)rB * D * ESZ))[F.lane + 64 * j] = pack4_fp8(hb.x, hb.y, hb.z, hb.w); }
                else { u32x2 o; o.x = cvt_pk_bf16(ha.x, ha.y); o.y = cvt_pk_bf16(ha.z, ha.w); ((u32x2*)(dbase + (size_t)r * D * ESZ))[F.lane + 64 * j] = o;
                       o.x = cvt_pk_bf16(hb.x, hb.y); o.y = cvt_pk_bf16(hb.z, hb.w); ((u32x2*)(dbase + (size_t)rB * D * ESZ))[F.lane + 64 * j] = o; } }
        }
    }
}

__device__ __forceinline__ void p10_final(Frame& F, int grp) {
    CArgs* ap = argp(); const float* fg = INP(23);
    const float* mod = WSP(float, WS_MOD); const bf16* ys = WSP(bf16, WS_YSLOT); const bf16* x1b = X1P(0);
    const int gw = F.blk * 8 + F.wave, NGW = F.G * 8, wps = NGW / NB, seq = gw / wps, wq = gw % wps, r0 = seq * T + wq, r1 = (seq < NB) ? (seq + 1) * T : 0, rstep = wps;
    f32x4 mg[4], mf[4]; int curb = -1;
#pragma unroll
    for (int j = 0; j < 4; ++j) mf[j] = ((const f32x4*)fg)[F.lane + 64 * j];
#if !MK_SKIP_MOE
    const unsigned* spos = WSP(unsigned, WS_SPOS); const float* topw = WSP(float, WS_TOPW);
    const int lz = F.lane >> 6;
    u32x4 cur_sp[2]; f32x4 cur_tw[2];
    if (r0 < r1) { const int rB0 = (r0 + rstep < r1) ? r0 + rstep : r0; cur_sp[0] = ((const u32x4*)spos)[r0 + lz]; cur_sp[1] = ((const u32x4*)spos)[rB0 + lz]; cur_tw[0] = ((const f32x4*)topw)[r0 + lz]; cur_tw[1] = ((const f32x4*)topw)[rB0 + lz]; }
#endif
    for (int r = r0; r < r1; r += 2 * rstep) {
        const size_t grow = (size_t)grp * TG + r; const int bsel = (int)(grow >> 11);
        if (bsel != curb) { const float* g2 = mod + (size_t)bsel * 6144 + 5120; curb = bsel;
#pragma unroll
            for (int j = 0; j < 4; ++j) mg[j] = ((const f32x4*)g2)[F.lane + 64 * j]; }
        const int rr[2] = {r, (r + rstep < r1) ? r + rstep : r};
        f32x4 v[2][4]; float sq[2] = {0.f, 0.f};
#if !MK_SKIP_MOE
        unsigned yrow[2][4]; float yw[2][4];
#pragma unroll
        for (int q = 0; q < 2; ++q) { const u32x4 sp = cur_sp[q]; const f32x4 tw = cur_tw[q];
            yrow[q][0] = F.LC[LC_PT + (sp.x >> 16)] * 256u + (sp.x & 0xffffu); yrow[q][1] = F.LC[LC_PT + (sp.y >> 16)] * 256u + (sp.y & 0xffffu);
            yrow[q][2] = F.LC[LC_PT + (sp.z >> 16)] * 256u + (sp.z & 0xffffu); yrow[q][3] = F.LC[LC_PT + (sp.w >> 16)] * 256u + (sp.w & 0xffffu);
            yw[q][0] = tw.x; yw[q][1] = tw.y; yw[q][2] = tw.z; yw[q][3] = tw.w; }
        { const int rn = (r + 2 * rstep < r1) ? r + 2 * rstep : r, rnB = (rn + rstep < r1) ? rn + rstep : rn;
          cur_sp[0] = ((const u32x4*)spos)[rn + lz]; cur_sp[1] = ((const u32x4*)spos)[rnB + lz]; cur_tw[0] = ((const f32x4*)topw)[rn + lz]; cur_tw[1] = ((const f32x4*)topw)[rnB + lz]; }
#endif
        u32x2 xw[2][4];
#if !MK_SKIP_MOE
        u32x2 yv[2][4][4];
#endif
#pragma unroll
        for (int q = 0; q < 2; ++q)
#pragma unroll
            for (int j = 0; j < 4; ++j) { xw[q][j] = __builtin_nontemporal_load((const u32x2*)(x1b + (size_t)rr[q] * X1S) + F.lane + 64 * j);
#if !MK_SKIP_MOE
#pragma unroll
                for (int k = 0; k < 4; ++k) yv[q][k][j] = __builtin_nontemporal_load((const u32x2*)(ys + (size_t)yrow[q][k] * D) + F.lane + 64 * j);
#endif
            }
        asm volatile("" ::: "memory");
#pragma unroll
        for (int q = 0; q < 2; ++q)
#pragma unroll
            for (int j = 0; j < 4; ++j) {
                v[q][j] = (f32x4){bflo(xw[q][j].x), bfhi(xw[q][j].x), bflo(xw[q][j].y), bfhi(xw[q][j].y)};
#if !MK_SKIP_MOE
                f32x4 y = (f32x4){0.f, 0.f, 0.f, 0.f};
#pragma unroll
                for (int k = 0; k < 4; ++k) { const u32x2 w = yv[q][k][j]; y += (f32x4){bflo(w.x), bfhi(w.x), bflo(w.y), bfhi(w.y)} * yw[q][k]; }
                v[q][j] += mg[j] * y;
#endif
                sq[q] += (v[q][j].x * v[q][j].x + v[q][j].y * v[q][j].y) + (v[q][j].z * v[q][j].z + v[q][j].w * v[q][j].w); }
#pragma unroll
        for (int q = 0; q < 2; ++q) { const float rstd = frsq(wave_sum(sq[q]) * (1.0f / D) + EPS); float* orow = (float*)(F.out + ((size_t)grp * TG + rr[q]) * D);
#pragma unroll
            for (int j = 0; j < 4; ++j) __builtin_nontemporal_store(v[q][j] * rstd * mf[j], (f32x4*)orow + F.lane + 64 * j); }
    }
}

using pg8::Unit;
template <int NCT> struct SchedProj {
    int G, c, n_lat, n_ctx; unsigned H, HC, W; int ct0; static constexpr unsigned ES = MK_P2_FP8 ? 1 : 2;
    __device__ __forceinline__ bool next(int i, Unit& u) const {
        int L = i * G + c; int pm, pn;
        if (L < n_lat) { pg8::map_tile<TG / 256, NCT>(L, pm, pn); pn += ct0; u.A = H + (unsigned)pm * 256 * D * ES; u.B0 = W + (unsigned)pn * 256 * D * ES; u.B1 = u.B0 + 128u * D * ES; u.r0 = pm * 256; u.c0 = pn * 256; u.aux = 0; u.aux2 = 0; u.aux3 = 0; return true; }
        L -= n_lat;
        if (L < n_ctx) { pg8::map_tile<NCTX / 256, 12>(L, pm, pn); u.A = HC + (unsigned)pm * 256 * D * ES; u.B0 = W + (unsigned)(1024 + pn * 256) * D * ES; u.B1 = u.B0 + 128u * D * ES; u.r0 = pm * 256; u.c0 = 1024 + pn * 256; u.aux = 1; u.aux2 = 0; u.aux3 = 0; return true; }
        return false;
    }
};
struct EpiProj {
    static constexpr bool BIAS = false; static constexpr bool PERM = true;
    bf16* Z; bf16* ZC; const float* lb; float* vstat;
    template <int KIND> __device__ __forceinline__ void body(const f32x4 (&acc)[2][2][4][2], const Unit& u, int wr, int wc, int fr, int fq) const {
        bf16* base; int ldc, colo;
        if (u.aux) { base = ZC; ldc = 3072; colo = u.c0 - 1024; } else { base = Z; ldc = INW; colo = u.c0; }
        const int col0 = colo + wc * 32 + 8 * fq, gcol0 = u.c0 + wc * 32 + 8 * fq;
        float lbv[2][8];
        if constexpr (KIND == 2) { const float* lp = lb + ((u.c0 >> 10) - 2) * 1024 + (gcol0 & 1023);
#pragma unroll
            for (int bj = 0; bj < 2; ++bj) { const f32x4 a = *(const f32x4*)(lp + bj * 128), b = *(const f32x4*)(lp + bj * 128 + 4);
                lbv[bj][0] = a.x; lbv[bj][1] = a.y; lbv[bj][2] = a.z; lbv[bj][3] = a.w; lbv[bj][4] = b.x; lbv[bj][5] = b.y; lbv[bj][6] = b.z; lbv[bj][7] = b.w; } }
#pragma unroll
        for (int ai = 0; ai < 2; ++ai)
#pragma unroll
            for (int m = 0; m < 4; ++m) {
                const int row = u.r0 + ai * 128 + wr * 64 + m * 16 + fr;
                bf16* rowp = base + (size_t)row * ldc + col0;
                float s1 = 0.f, s2 = 0.f;
#pragma unroll
                for (int bj = 0; bj < 2; ++bj) {
                    float v[8];
#pragma unroll
                    for (int j = 0; j < 4; ++j) { v[j] = acc[ai][bj][m][0][j] * (MK_P2_FP8 ? W8_INV : 1.0f); v[4 + j] = acc[ai][bj][m][1][j] * (MK_P2_FP8 ? W8_INV : 1.0f); }
                    if constexpr (KIND == 0) {
#pragma unroll
                        for (int j = 0; j < 8; ++j) v[j] = v[j] * fsigmoid(v[j]);
                    } else if constexpr (KIND == 2) {
#pragma unroll
                        for (int j = 0; j < 8; ++j) v[j] = __builtin_amdgcn_logf(lbv[bj][j] + (1.0f - lbv[bj][j]) * fsigmoid(v[j]));
                    } else if constexpr (KIND == 3 || KIND == 4) {
#pragma unroll
                        for (int j = 0; j < 8; j += 2) { const f32x2 g = gelu_pk((f32x2){v[j], v[j + 1]}); v[j] = g.x; v[j + 1] = g.y; }
                    } else if constexpr (KIND == 5) {
#pragma unroll
                        for (int j = 0; j < 8; ++j) v[j] = fsigmoid(v[j]);
                    }
                    u32x4 w; w.x = cvt_pk_bf16(v[0], v[1]); w.y = cvt_pk_bf16(v[2], v[3]); w.z = cvt_pk_bf16(v[4], v[5]); w.w = cvt_pk_bf16(v[6], v[7]);
                    *(u32x4*)(rowp + bj * 128) = w;
                    if constexpr (KIND == 4) {
                        const float r0 = bflo(w.x), r1 = bfhi(w.x), r2 = bflo(w.y), r3 = bfhi(w.y), r4 = bflo(w.z), r5 = bfhi(w.z), r6 = bflo(w.w), r7 = bfhi(w.w);
                        s1 += ((r0 + r1) + (r2 + r3)) + ((r4 + r5) + (r6 + r7));
                        s2 += ((r0 * r0 + r1 * r1) + (r2 * r2 + r3 * r3)) + ((r4 * r4 + r5 * r5) + (r6 * r6 + r7 * r7)); }
                }
                if constexpr (KIND == 4) {
                    s1 += SWZ_XOR(s1, 16); s1 = add_xor32(s1); s2 += SWZ_XOR(s2, 16); s2 = add_xor32(s2);
                    if (fq == 0) *(f32x2*)(vstat + ((size_t)row * 16 + ((u.c0 - 6144) >> 8) * 4 + wc) * 2) = (f32x2){s1, s2}; }
            }
    }
    __device__ __forceinline__ void operator()(const f32x4 (&acc)[2][2][4][2], const Unit& u, int wr, int wc, int fr, int fq) const {
        const int seg = u.c0 >> 10;
        if (seg == 0) body<0>(acc, u, wr, wc, fr, fq);
        else if (seg == 1 || seg == 4) body<1>(acc, u, wr, wc, fr, fq);
        else if (seg == 2 || seg == 3) body<2>(acc, u, wr, wc, fr, fq);
        else if (seg == 5) body<3>(acc, u, wr, wc, fr, fq);
        else if (seg == 6) body<4>(acc, u, wr, wc, fr, fq);
        else body<5>(acc, u, wr, wc, fr, fq);
    }
};

struct SchedBranch {
    int G, c; unsigned YA, YB, WA, WB; static constexpr unsigned ES = MK_P5_FP8 ? 1 : 2;
    __device__ __forceinline__ bool next(int i, Unit& u) const {
        const int L = (i >> 1) * G + c, which = i & 1; if (L >= (TG / 256) * 4) return false;
        int pm, pn; pg8::map_tile<TG / 256, 4>(L, pm, pn);
        u.A = (which ? YB : YA) + (unsigned)pm * 256 * D * ES; u.B0 = (which ? WB : WA) + (unsigned)pn * 256 * D * ES; u.B1 = u.B0 + 128u * D * ES;
        u.r0 = pm * 256; u.c0 = pn * 256; u.aux = which; u.aux2 = 0; u.aux3 = 0; return true;
    }
};
struct EpiBranch {
    static constexpr bool BIAS = false; static constexpr bool PERM = true;
    const bf16* Z; bf16* Tb; bf16* M;
    template <int Q, bool AUX> __device__ __forceinline__ void loadq(const Unit& u, const size_t rowb, const int cb, const int gcol, u32x4 (&g)[2], u32x4 (&t)[2]) const {
        const size_t row = rowb + (Q >> 2) * 128 + (Q & 3) * 16;
#pragma unroll
        for (int bj = 0; bj < 2; ++bj) { g[bj] = *(const u32x4*)(Z + row * INW + gcol + cb + bj * 128); if constexpr (AUX) t[bj] = *(const u32x4*)(Tb + row * D + cb + bj * 128); }
        asm volatile("" ::: "memory");
    }
    template <int Q, bool AUX> __device__ __forceinline__ void compq(const f32x4 (&acc)[2][2][4][2], const Unit& u, const size_t rowb, const int cb, const u32x4 (&g)[2], const u32x4 (&t)[2]) const {
        constexpr int ai = Q >> 2, m = Q & 3; const size_t row = rowb + ai * 128 + m * 16;
#pragma unroll
        for (int bj = 0; bj < 2; ++bj) {
            const u32x4 gg = g[bj]; const unsigned gw[4] = {gg.x, gg.y, gg.z, gg.w};
            const u32x4 tt = t[bj]; const unsigned tw[4] = {tt.x, tt.y, tt.z, tt.w};
            float r[8];
#pragma unroll
            for (int j = 0; j < 8; ++j) { const float a = (j < 4 ? acc[ai][bj][m][0][j & 3] : acc[ai][bj][m][1][j & 3]) * (MK_P5_FP8 ? W8_INV : 1.0f);
                const float gv = (j & 1) ? bfhi(gw[j >> 1]) : bflo(gw[j >> 1]);
                r[j] = AUX ? ((j & 1) ? bfhi(tw[j >> 1]) : bflo(tw[j >> 1])) + a * gv : a * gv; }
            if constexpr (!AUX) { u32x4 o; o.x = cvt_pk_bf16(r[0], r[1]); o.y = cvt_pk_bf16(r[2], r[3]); o.z = cvt_pk_bf16(r[4], r[5]); o.w = cvt_pk_bf16(r[6], r[7]); *(u32x4*)(Tb + row * D + cb + bj * 128) = o; }
            else if (MK_P6_FP8) { u32x2 o; o.x = pack4_fp8(r[0], r[1], r[2], r[3]); o.y = pack4_fp8(r[4], r[5], r[6], r[7]); *(u32x2*)((unsigned char*)M + row * D + cb + bj * 128) = o; }
            else { u32x4 o; o.x = cvt_pk_bf16(r[0], r[1]); o.y = cvt_pk_bf16(r[2], r[3]); o.z = cvt_pk_bf16(r[4], r[5]); o.w = cvt_pk_bf16(r[6], r[7]); *(u32x4*)(M + row * D + cb + bj * 128) = o; } }
        asm volatile("" ::: "memory");
    }
    template <bool AUX> __device__ __forceinline__ void run(const f32x4 (&acc)[2][2][4][2], const Unit& u, int wr, int wc, int fr, int fq) const {
        const int gcol = AUX ? 8192 : 7168, cb = u.c0 + wc * 32 + 8 * fq; const size_t rowb = (size_t)(u.r0 + wr * 64 + fr);
        u32x4 gA[2], tA[2], gB[2], tB[2], gC[2], tC[2];
#pragma unroll
        for (int b = 0; b < 2; ++b) { tA[b] = (u32x4){0u, 0u, 0u, 0u}; tB[b] = tA[b]; tC[b] = tA[b]; }
        loadq<0, AUX>(u, rowb, cb, gcol, gA, tA); loadq<1, AUX>(u, rowb, cb, gcol, gB, tB);
        loadq<2, AUX>(u, rowb, cb, gcol, gC, tC); compq<0, AUX>(acc, u, rowb, cb, gA, tA);
        loadq<3, AUX>(u, rowb, cb, gcol, gA, tA); compq<1, AUX>(acc, u, rowb, cb, gB, tB);
        loadq<4, AUX>(u, rowb, cb, gcol, gB, tB); compq<2, AUX>(acc, u, rowb, cb, gC, tC);
        loadq<5, AUX>(u, rowb, cb, gcol, gC, tC); compq<3, AUX>(acc, u, rowb, cb, gA, tA);
        loadq<6, AUX>(u, rowb, cb, gcol, gA, tA); compq<4, AUX>(acc, u, rowb, cb, gB, tB);
        loadq<7, AUX>(u, rowb, cb, gcol, gB, tB); compq<5, AUX>(acc, u, rowb, cb, gC, tC);
        compq<6, AUX>(acc, u, rowb, cb, gA, tA); compq<7, AUX>(acc, u, rowb, cb, gB, tB);
    }
    __device__ __forceinline__ void operator()(const f32x4 (&acc)[2][2][4][2], const Unit& u, int wr, int wc, int fr, int fq) const {
        if (u.aux) run<true>(acc, u, wr, wc, fr, fq); else run<false>(acc, u, wr, wc, fr, fq);
    }
};

struct SchedOut {
    int G, c; unsigned MG, W; static constexpr unsigned ES = MK_P6_FP8 ? 1 : 2;
    __device__ __forceinline__ bool next(int i, Unit& u) const {
        const int L = i * G + c; if (L >= (TG / 256) * 4) return false;
        int pm, pn; pg8::map_tile<TG / 256, 4>(L, pm, pn);
        u.A = MG + (unsigned)pm * 256 * D * ES; u.B0 = W + (unsigned)pn * 256 * D * ES; u.B1 = u.B0 + 128u * D * ES; u.r0 = pm * 256; u.c0 = pn * 256; u.aux = 0; u.aux2 = 0; u.aux3 = 0; return true;
    }
};
struct EpiOut {
    static constexpr bool BIAS = false; static constexpr bool PERM = true;
    const float* x; bf16* x1b; const float* mod; int grp;
    template <int Q> __device__ __forceinline__ void loadq(const float* xb, f32x4 (&xv)[2][2]) const {
        const float* rp = xb + (size_t)((Q >> 2) * 128 + (Q & 3) * 16) * D;
#pragma unroll
        for (int bj = 0; bj < 2; ++bj) { xv[bj][0] = *(const f32x4*)(rp + bj * 128); xv[bj][1] = *(const f32x4*)(rp + bj * 128 + 4); }
        asm volatile("" ::: "memory");
    }
    template <int Q> __device__ __forceinline__ void compq(const f32x4 (&acc)[2][2][4][2], bf16* ob, const f32x4 (&gv)[2][2], const f32x4 (&xv)[2][2]) const {
        constexpr int ai = Q >> 2, m = Q & 3; bf16* rp = ob + (size_t)(ai * 128 + m * 16) * X1S;
#pragma unroll
        for (int bj = 0; bj < 2; ++bj) {
            const f32x4 r0 = xv[bj][0] + gv[bj][0] * (acc[ai][bj][m][0] * (MK_P6_FP8 ? W8_INV : 1.0f)), r1 = xv[bj][1] + gv[bj][1] * (acc[ai][bj][m][1] * (MK_P6_FP8 ? W8_INV : 1.0f));
            u32x4 o; o.x = cvt_pk_bf16(r0.x, r0.y); o.y = cvt_pk_bf16(r0.z, r0.w); o.z = cvt_pk_bf16(r1.x, r1.y); o.w = cvt_pk_bf16(r1.z, r1.w);
            *(u32x4*)(rp + bj * 128) = o; }
        asm volatile("" ::: "memory");
    }
    __device__ __forceinline__ void operator()(const f32x4 (&acc)[2][2][4][2], const Unit& u, int wr, int wc, int fr, int fq) const {
        const size_t grow0 = (size_t)grp * TG + u.r0;
        const float* g1 = mod + (grow0 >> 11) * 6144 + 2048;
        const int cb = u.c0 + wc * 32 + 8 * fq;
        const float* xb = x + (grow0 + wr * 64 + fr) * D + cb; bf16* ob = x1b + (size_t)(u.r0 + wr * 64 + fr) * X1S + cb;
        f32x4 gv[2][2];
#pragma unroll
        for (int bj = 0; bj < 2; ++bj) { gv[bj][0] = *(const f32x4*)(g1 + cb + bj * 128); gv[bj][1] = *(const f32x4*)(g1 + cb + bj * 128 + 4); }
        f32x4 xA[2][2], xB[2][2], xC[2][2];
        loadq<0>(xb, xA); loadq<1>(xb, xB);
        loadq<2>(xb, xC); compq<0>(acc, ob, gv, xA);
        loadq<3>(xb, xA); compq<1>(acc, ob, gv, xB);
        loadq<4>(xb, xB); compq<2>(acc, ob, gv, xC);
        loadq<5>(xb, xC); compq<3>(acc, ob, gv, xA);
        loadq<6>(xb, xA); compq<4>(acc, ob, gv, xB);
        loadq<7>(xb, xB); compq<5>(acc, ob, gv, xC);
        compq<6>(acc, ob, gv, xA); compq<7>(acc, ob, gv, xB);
    }
};

struct SchedMoe {
    int G, c, nct_shift; const volatile LAS unsigned* LC; unsigned Abase, W; const unsigned* list; bool second;
    __device__ __forceinline__ bool next(int i, Unit& u) const {
        const int x = c & 7, j = c >> 3, sr = i * 8 + x;
        const int rtg = nct_shift == 3 ? sr * 4 + (j >> 3) : sr * 8 + (j >> 2), ct = j & ((1 << nct_shift) - 1);
        if (rtg >= __builtin_amdgcn_readfirstlane((int)LC[LC_PT + 32])) return false;
        const int e = __builtin_amdgcn_readfirstlane((int)((LC[LC_EXPT + (rtg >> 2)] >> (8 * (rtg & 3))) & 0xffu));
        const int pt = __builtin_amdgcn_readfirstlane((int)LC[LC_PT + e]), rt = rtg - pt;
        u.aux = e; u.aux2 = rt * 256; u.aux3 = __builtin_amdgcn_readfirstlane((int)LC[LC_CNT + e]);
        if (!second) { u.A = Abase; u.B0 = W + (unsigned)(e * 2 * FE + 128 * ct) * D; u.B1 = W + (unsigned)(e * 2 * FE + FE + 128 * ct) * D; u.r0 = (pt + rt) * 256; u.c0 = 128 * ct; }
        else { u.A = Abase + (unsigned)(pt + rt) * 256 * FE; u.B0 = W + (unsigned)(e * D + 256 * ct) * FE; u.B1 = u.B0 + 128u * FE; u.r0 = (pt + rt) * 256; u.c0 = 256 * ct; }
        return true;
    }
    __device__ __forceinline__ void a_offsets(const Unit& u, const int wid, unsigned (&v)[2][2]) const {
        const int tid = wid * 64 + lane_now();
        int Rr[2], Cc[2];
#pragma unroll
        for (int i = 0; i < 2; ++i) pg8::stage_rc(tid * 16 + i * 8192, Rr[i], Cc[i]);
#pragma unroll
        for (int h = 0; h < 2; ++h)
#pragma unroll
            for (int i = 0; i < 2; ++i) { int idx = u.aux2 + h * 128 + Rr[i]; idx = idx < u.aux3 ? idx : u.aux3 - 1; const unsigned ent = list[(size_t)u.aux * TGM + idx]; v[h][i] = (ent >> 2) * (unsigned)D + 2u * (unsigned)Cc[i]; }
    }
};
struct EpiMoe1 {
    static constexpr bool BIAS = true; static constexpr bool PERM = true;
    unsigned char* ACT; const float* b1;
    __device__ __forceinline__ void bias_dma(LAS unsigned char* dst, const Unit& u) const {
        const int l = lane_now(); const __amdgpu_buffer_rsrc_t r = __builtin_amdgcn_make_buffer_rsrc((void*)b1, 0, 0x7fffffff, 0x00020000);
        __builtin_amdgcn_raw_ptr_buffer_load_lds(r, (LAS void*)dst, 16, (int)((((l >> 5) * FE) + u.c0 + 4 * (l & 31)) * 4), (int)(u.aux * 2 * FE * 4), 0, 0);
    }
    __device__ __forceinline__ void operator()(const f32x4 (&acc)[2][2][4][2], const Unit& u, int wr, int wc, int fr, int fq, const LAS unsigned char* lb) const {
        const int col0 = u.c0 + wc * 32 + 8 * fq; const LAS float* bp = (const LAS float*)lb + wc * 32 + 8 * fq;
        float bg[8], bl[8];
        { const f32x4 a = *(const LAS f32x4*)bp, b = *(const LAS f32x4*)(bp + 4), c = *(const LAS f32x4*)(bp + 128), d = *(const LAS f32x4*)(bp + 128 + 4);
          bg[0] = a.x; bg[1] = a.y; bg[2] = a.z; bg[3] = a.w; bg[4] = b.x; bg[5] = b.y; bg[6] = b.z; bg[7] = b.w; bl[0] = c.x; bl[1] = c.y; bl[2] = c.z; bl[3] = c.w; bl[4] = d.x; bl[5] = d.y; bl[6] = d.z; bl[7] = d.w; }
#pragma unroll
        for (int ai = 0; ai < 2; ++ai)
#pragma unroll
            for (int m = 0; m < 4; ++m) {
                const int row = u.r0 + ai * 128 + wr * 64 + m * 16 + fr;
                float v[8];
#pragma unroll
                for (int j = 0; j < 8; ++j) { const float zg = __builtin_fmaf((j < 4 ? acc[ai][0][m][0][j & 3] : acc[ai][0][m][1][j & 3]), W8_INV, bg[j]), zl = __builtin_fmaf((j < 4 ? acc[ai][1][m][0][j & 3] : acc[ai][1][m][1][j & 3]), W8_INV, bl[j]);
                    const float gate = __builtin_fminf(zg, 7.0f), lin = __builtin_amdgcn_fmed3f(zl, -7.0f, 7.0f);
                    const float p = gate * frcp(1.0f + __builtin_amdgcn_exp2f(gate * (-1.702f * 1.44269504089f))); v[j] = __builtin_fmaf(p, lin, p); }
                u32x2 w; { int p0 = __builtin_amdgcn_cvt_pk_fp8_f32(v[0], v[1], 0, false); p0 = __builtin_amdgcn_cvt_pk_fp8_f32(v[2], v[3], p0, true); int p1 = __builtin_amdgcn_cvt_pk_fp8_f32(v[4], v[5], 0, false); p1 = __builtin_amdgcn_cvt_pk_fp8_f32(v[6], v[7], p1, true); w.x = (unsigned)p0; w.y = (unsigned)p1; }
                *(u32x2*)(ACT + (size_t)row * FE + col0) = w;
            }
    }
};
struct EpiMoe2 {
    static constexpr bool BIAS = true; static constexpr bool PERM = true;
    bf16* YS; const float* b2;
    __device__ __forceinline__ void bias_dma(LAS unsigned char* dst, const Unit& u) const {
        const int l = lane_now(); const __amdgpu_buffer_rsrc_t r = __builtin_amdgcn_make_buffer_rsrc((void*)b2, 0, 0x7fffffff, 0x00020000);
        __builtin_amdgcn_raw_ptr_buffer_load_lds(r, (LAS void*)dst, 16, (int)((u.c0 + 4 * l) * 4), (int)(u.aux * D * 4), 0, 0);
    }
    __device__ __forceinline__ void operator()(const f32x4 (&acc)[2][2][4][2], const Unit& u, int wr, int wc, int fr, int fq, const LAS unsigned char* lb) const {
        const int col0 = u.c0 + wc * 32 + 8 * fq; const LAS float* bp = (const LAS float*)lb + wc * 32 + 8 * fq;
        float bv[2][8];
#pragma unroll
        for (int bj = 0; bj < 2; ++bj) { const f32x4 a = *(const LAS f32x4*)(bp + bj * 128), b = *(const LAS f32x4*)(bp + bj * 128 + 4);
            bv[bj][0] = a.x; bv[bj][1] = a.y; bv[bj][2] = a.z; bv[bj][3] = a.w; bv[bj][4] = b.x; bv[bj][5] = b.y; bv[bj][6] = b.z; bv[bj][7] = b.w; }
#pragma unroll
        for (int ai = 0; ai < 2; ++ai) {
#pragma unroll
            for (int m = 0; m < 4; ++m) {
                const int lr = ai * 128 + wr * 64 + m * 16 + fr;
                if (u.aux2 + lr < u.aux3) {
                    bf16* rowp = YS + (size_t)(u.r0 + lr) * D + col0;
#pragma unroll
                    for (int bj = 0; bj < 2; ++bj) {
                        float v[8];
#pragma unroll
                        for (int j = 0; j < 8; ++j) v[j] = (j < 4 ? acc[ai][bj][m][0][j & 3] : acc[ai][bj][m][1][j & 3]) * W8_INV + bv[bj][j];
                        u32x4 o; o.x = cvt_pk_bf16(v[0], v[1]); o.y = cvt_pk_bf16(v[2], v[3]); o.z = cvt_pk_bf16(v[4], v[5]); o.w = cvt_pk_bf16(v[6], v[7]);
                        *(u32x4*)(rowp + bj * 128) = o; }
                }
            }
        }
    }
};
__device__ __forceinline__ void moe_tables(Frame& F, int grp) {
    if (F.tid < 32) F.LC[LC_CNT + F.tid] = __hip_atomic_load(F.ctl + CW_CNT + (grp * 32 + F.tid) * 64, __ATOMIC_RELAXED, __HIP_MEMORY_SCOPE_AGENT);
    __syncthreads();
    if (F.tid == 0) { unsigned p = 0; for (int e = 0; e < 32; ++e) { F.LC[LC_PT + e] = p; p += (F.LC[LC_CNT + e] + 255u) >> 8; } F.LC[LC_PT + 32] = p; }
    __syncthreads();
    if (F.tid < (TGM * 4 / 256 + 32) / 4) {
        unsigned wv = 0u;
        for (int q = 0; q < 4; ++q) { const unsigned rtg = 4u * F.tid + q; unsigned e = 0u; for (int k = 1; k < 32; ++k) e = (rtg >= F.LC[LC_PT + k]) ? (unsigned)k : e; wv |= e << (8 * q); }
        F.LC[LC_EXPT + F.tid] = wv; }
    __syncthreads();
}

constexpr int GL_QS = 0, GL_KS = 17408, GL_QB = 34816, GL_KBT = 52224, GL_VT = 70656, GL_P = 79872, GL_ST = 89088, GL_TOT = 106496, GL_EE = 110592;
constexpr int ST128 = 272, ST64 = 144;
#define MFMA16(a, b, c) __builtin_amdgcn_mfma_f32_16x16x32_bf16((a), (b), (c), 0, 0, 0)
__device__ __forceinline__ void p3_gla(Frame& F, int grp) {
    const bf16* Z = WSP(bf16, WS_Z); const bf16* ZC = WSP(bf16, WS_ZC);
    LAS unsigned char* L = F.lds;
    const int lane = F.lane, w = F.wave, fr = lane & 15, fq = lane >> 4;
    for (int it = F.blk; it < GB * 8 * 2 * 2; it += F.G) {
        const int vh = it & 1, dir = (it >> 1) & 1, h = (it >> 2) & 7, bl = it >> 5, b = grp * GB + bl;
        bf16* O = WSP(bf16, dir ? WS_OB : WS_OF);
        f32x4 accS[4];
#pragma unroll
        for (int i = 0; i < 4; ++i) accS[i] = (f32x4){0.f, 0.f, 0.f, 0.f};
        unsigned rq[8], rg[8]; unsigned short rv[8];
#define GLA_LOAD(st_) do { const int s__ = (st_); \
            if (s__ < 4) { const int cc = dir ? 3 - s__ : s__; const bf16* bp = ZC + (size_t)(b * CTXL + cc * 64 + 8 * w) * 3072; \
                _Pragma("unroll") for (int i = 0; i < 8; ++i) { rq[i] = 0u; rg[i] = *(const unsigned*)(bp + (size_t)i * 3072 + 1024 + dir * 1024 + h * 128 + 2 * lane); rv[i] = bp[(size_t)i * 3072 + h * 128 + vh * 64 + lane]; } } \
            else { const int lc = dir ? 35 - s__ : s__ - 4; const bf16* bp = Z + (size_t)(bl * T + lc * 64 + 8 * w) * INW; \
                _Pragma("unroll") for (int i = 0; i < 8; ++i) { rq[i] = *(const unsigned*)(bp + (size_t)i * INW + h * 128 + 2 * lane); rg[i] = *(const unsigned*)(bp + (size_t)i * INW + 2048 + dir * 1024 + h * 128 + 2 * lane); rv[i] = bp[(size_t)i * INW + 1024 + h * 128 + vh * 64 + lane]; } } } while (0)
        GLA_LOAD(0);
        for (int st = 0; st < 36; ++st) {
            const bool lat = st >= 4;
            float p0[8], p1[8], tot0 = 0.f, tot1 = 0.f;
            if (dir == 0) {
#pragma unroll
                for (int i = 0; i < 8; ++i) { tot0 += bflo(rg[i]); tot1 += bfhi(rg[i]); p0[i] = tot0; p1[i] = tot1; }
            } else {
#pragma unroll
                for (int i = 7; i >= 0; --i) { tot0 += bflo(rg[i]); tot1 += bfhi(rg[i]); p0[i] = tot0; p1[i] = tot1; }
            }
            *(LAS f32x2*)(L + GL_TOT + (w * 128 + 2 * lane) * 4) = (f32x2){tot0, tot1};
            __syncthreads();
            float off0 = 0.f, off1 = 0.f, bend0 = 0.f, bend1 = 0.f, bref0 = 0.f, bref1 = 0.f;
#pragma unroll
            for (int k = 0; k < 8; ++k) { const f32x2 t = *(const LAS f32x2*)(L + GL_TOT + (k * 128 + 2 * lane) * 4);
                const bool before = dir ? (k > w) : (k < w), inref = dir ? (k >= 4) : (k < 4);
                off0 += before ? t.x : 0.f; off1 += before ? t.y : 0.f; bend0 += t.x; bend1 += t.y; bref0 += inref ? t.x : 0.f; bref1 += inref ? t.y : 0.f; }
            const float eref0 = fexp(bref0), eref1 = fexp(bref1), eer0 = fexp(bend0 - bref0), eer1 = fexp(bend1 - bref1);
            float kb0[8], kb1[8];
#pragma unroll
            for (int i = 0; i < 8; ++i) {
                const float b0 = off0 + p0[i], b1 = off1 + p1[i];
                const float eq0 = fexp(b0 - bref0), eq1 = fexp(b1 - bref1), ek0 = frcp(eq0), ek1 = frcp(eq1);
                const float k0 = 1.0f - fexp(bflo(rg[i])), k1 = 1.0f - fexp(bfhi(rg[i]));
                const float ks0 = k0 * ek0, ks1 = k1 * ek1;
                kb0[i] = ks0 * eer0; kb1[i] = ks1 * eer1;
                if (lat) {
                    const float q0 = bflo(rq[i]), q1 = bfhi(rq[i]), qs0 = q0 * eq0, qs1 = q1 * eq1;
                    const int s = 8 * w + i;
                    *(LAS unsigned*)(L + GL_QS + s * ST128 + 4 * lane) = cvt_pk_bf16(qs0, qs1);
                    *(LAS unsigned*)(L + GL_KS + s * ST128 + 4 * lane) = cvt_pk_bf16(ks0, ks1);
                    *(LAS unsigned*)(L + GL_QB + s * ST128 + 4 * lane) = cvt_pk_bf16(qs0 * eref0, qs1 * eref1);
                }
            }
            { u32x4 o; o.x = cvt_pk_bf16(kb0[0], kb0[1]); o.y = cvt_pk_bf16(kb0[2], kb0[3]); o.z = cvt_pk_bf16(kb0[4], kb0[5]); o.w = cvt_pk_bf16(kb0[6], kb0[7]);
              *(LAS u32x4*)(L + GL_KBT + (2 * lane) * ST64 + 16 * w) = o;
              o.x = cvt_pk_bf16(kb1[0], kb1[1]); o.y = cvt_pk_bf16(kb1[2], kb1[3]); o.z = cvt_pk_bf16(kb1[4], kb1[5]); o.w = cvt_pk_bf16(kb1[6], kb1[7]);
              *(LAS u32x4*)(L + GL_KBT + (2 * lane + 1) * ST64 + 16 * w) = o;
              o.x = (unsigned)rv[0] | ((unsigned)rv[1] << 16); o.y = (unsigned)rv[2] | ((unsigned)rv[3] << 16); o.z = (unsigned)rv[4] | ((unsigned)rv[5] << 16); o.w = (unsigned)rv[6] | ((unsigned)rv[7] << 16);
              *(LAS u32x4*)(L + GL_VT + lane * ST64 + 16 * w) = o; }
            if (w == 0) *(LAS f32x2*)(L + GL_EE + 8 * lane) = (f32x2){fexp(bend0), fexp(bend1)};
            const int lc = dir ? 35 - st : st - 4;
            if (st + 1 < 36) GLA_LOAD(st + 1);
            __syncthreads();
            if (lat) {
#pragma unroll
                for (int x = 0; x < 2; ++x) {
                    const int id = 2 * w + x, sti = id >> 2, tti = id & 3;
                    f32x4 a = (f32x4){0.f, 0.f, 0.f, 0.f};
#pragma unroll
                    for (int ks = 0; ks < 4; ++ks) {
                        const bf16x8 fa = *(const LAS bf16x8*)(L + GL_KS + (16 * sti + fr) * ST128 + (32 * ks + 8 * fq) * 2);
                        const bf16x8 fb = *(const LAS bf16x8*)(L + GL_QS + (16 * tti + fr) * ST128 + (32 * ks + 8 * fq) * 2);
                        a = MFMA16(fa, fb, a); }
                    const int t = 16 * tti + fr, s0 = 16 * sti + 4 * fq;
                    float v[4];
#pragma unroll
                    for (int r = 0; r < 4; ++r) { const int s = s0 + r; const bool keep = dir ? (s >= t) : (s <= t); v[r] = keep ? a[r] : 0.f; }
                    u32x2 o; o.x = cvt_pk_bf16(v[0], v[1]); o.y = cvt_pk_bf16(v[2], v[3]);
                    *(LAS u32x2*)(L + GL_P + t * ST64 + 2 * s0) = o;
                }
                __syncthreads();
#pragma unroll
                for (int x = 0; x < 2; ++x) {
                    const int id = 2 * w + x, vti = id >> 2, tti = id & 3;
                    f32x4 o = (f32x4){0.f, 0.f, 0.f, 0.f};
                    if (MK_GLA_MODE != 3)
#pragma unroll
                    for (int ks = 0; ks < 2; ++ks) {
                        const bf16x8 fa = *(const LAS bf16x8*)(L + GL_VT + (16 * vti + fr) * ST64 + (32 * ks + 8 * fq) * 2);
                        const bf16x8 fb = *(const LAS bf16x8*)(L + GL_P + (16 * tti + fr) * ST64 + (32 * ks + 8 * fq) * 2);
                        o = MFMA16(fa, fb, o); }
                    if (MK_GLA_MODE != 2)
#pragma unroll
                    for (int ks = 0; ks < 4; ++ks) {
                        const bf16x8 fa = *(const LAS bf16x8*)(L + GL_ST + (16 * vti + fr) * ST128 + (32 * ks + 8 * fq) * 2);
                        const bf16x8 fb = *(const LAS bf16x8*)(L + GL_QB + (16 * tti + fr) * ST128 + (32 * ks + 8 * fq) * 2);
                        o = MFMA16(fa, fb, o); }
                    const int t = 16 * tti + fr; const size_t row = (size_t)bl * T + lc * 64 + t;
                    u32x2 ov; ov.x = cvt_pk_bf16(o[0], o[1]); ov.y = cvt_pk_bf16(o[2], o[3]);
                    *(u32x2*)(O + row * D + h * 128 + vh * 64 + 16 * vti + 4 * fq) = ov;
                }
            }
            { const f32x4 ee = *(const LAS f32x4*)(L + GL_EE + (16 * w + 4 * fq) * 4);
#pragma unroll
              for (int vt = 0; vt < 4; ++vt) accS[vt] *= ee;
#pragma unroll
              for (int ks = 0; ks < 2; ++ks) {
                  const bf16x8 fa = *(const LAS bf16x8*)(L + GL_KBT + (16 * w + fr) * ST64 + (32 * ks + 8 * fq) * 2);
#pragma unroll
                  for (int vt = 0; vt < 4; ++vt) { const bf16x8 fb = *(const LAS bf16x8*)(L + GL_VT + (16 * vt + fr) * ST64 + (32 * ks + 8 * fq) * 2); accS[vt] = MFMA16(fa, fb, accS[vt]); } } }
            __syncthreads();
#pragma unroll
            for (int vt = 0; vt < 4; ++vt) { u32x2 o; o.x = cvt_pk_bf16(accS[vt][0], accS[vt][1]); o.y = cvt_pk_bf16(accS[vt][2], accS[vt][3]);
                *(LAS u32x2*)(L + GL_ST + (16 * vt + fr) * ST128 + 2 * (16 * w + 4 * fq)) = o; }
        }
#undef GLA_LOAD
        __syncthreads();
    }
}

constexpr int NGLA = GB * 8 * 2;
constexpr int GF_QS = 0, GF_KS = 17408, GF_QB = 34816, GF_KBT = 52224, GF_VT = 70656, GF_P = 89088, GF_ST = 98304, GF_TOT = 133120, GF_EE = 137216;
static_assert(GF_EE + 512 <= RING_BYTES + 15360, "full scan LDS map");
__device__ __forceinline__ void p3_gla_full(Frame& F, int grp) {
    const bf16* Z = WSP(bf16, WS_Z); const bf16* ZC = WSP(bf16, WS_ZC);
    LAS unsigned char* L = F.lds;
    const int lane = F.lane, w = F.wave, fr = lane & 15, fq = lane >> 4;
    for (int it = F.blk; it < NGLA; it += F.G) {
        const int dir = it & 1, h = (it >> 1) & 7, bl = it >> 4, b = grp * GB + bl;
        bf16* O = WSP(bf16, dir ? WS_OB : WS_OF);
        f32x4 accS[8];
#pragma unroll
        for (int i = 0; i < 8; ++i) accS[i] = (f32x4){0.f, 0.f, 0.f, 0.f};
        unsigned rq[8], rg[8], rv[8];
#define GLF_LOAD(st_) do { const int s__ = (st_); \
            if (s__ < 4) { const int cc = dir ? 3 - s__ : s__; const bf16* bp = ZC + (size_t)(b * CTXL + cc * 64 + 8 * w) * 3072; \
                _Pragma("unroll") for (int i = 0; i < 8; ++i) { rq[i] = 0u; rg[i] = *(const unsigned*)(bp + (size_t)i * 3072 + 1024 + dir * 1024 + h * 128 + 2 * lane); rv[i] = *(const unsigned*)(bp + (size_t)i * 3072 + h * 128 + 2 * lane); } } \
            else { const int lc_ = dir ? 35 - s__ : s__ - 4; const bf16* bp = Z + (size_t)(bl * T + lc_ * 64 + 8 * w) * INW; \
                _Pragma("unroll") for (int i = 0; i < 8; ++i) { rq[i] = *(const unsigned*)(bp + (size_t)i * INW + h * 128 + 2 * lane); rg[i] = *(const unsigned*)(bp + (size_t)i * INW + 2048 + dir * 1024 + h * 128 + 2 * lane); rv[i] = *(const unsigned*)(bp + (size_t)i * INW + 1024 + h * 128 + 2 * lane); } } } while (0)
        GLF_LOAD(0);
        for (int st = 0; st < 36; ++st) {
            const bool lat = st >= 4;
            float p0[8], p1[8], tot0 = 0.f, tot1 = 0.f;
            if (dir == 0) {
#pragma unroll
                for (int i = 0; i < 8; ++i) { tot0 += bflo(rg[i]); tot1 += bfhi(rg[i]); p0[i] = tot0; p1[i] = tot1; }
            } else {
#pragma unroll
                for (int i = 7; i >= 0; --i) { tot0 += bflo(rg[i]); tot1 += bfhi(rg[i]); p0[i] = tot0; p1[i] = tot1; }
            }
            *(LAS f32x2*)(L + GF_TOT + (w * 128 + 2 * lane) * 4) = (f32x2){tot0, tot1};
            LDSBAR();
            float off0 = 0.f, off1 = 0.f, bend0 = 0.f, bend1 = 0.f, bref0 = 0.f, bref1 = 0.f;
#pragma unroll
            for (int k = 0; k < 8; ++k) { const f32x2 t = *(const LAS f32x2*)(L + GF_TOT + (k * 128 + 2 * lane) * 4);
                const bool before = dir ? (k > w) : (k < w), inref = dir ? (k >= 4) : (k < 4);
                off0 += before ? t.x : 0.f; off1 += before ? t.y : 0.f; bend0 += t.x; bend1 += t.y; bref0 += inref ? t.x : 0.f; bref1 += inref ? t.y : 0.f; }
            const float eer0 = __builtin_amdgcn_exp2f(bend0 - bref0), eer1 = __builtin_amdgcn_exp2f(bend1 - bref1);
            float kb0[8], kb1[8];
#pragma unroll
            for (int i = 0; i < 8; ++i) {
                const float b0 = off0 + p0[i], b1 = off1 + p1[i];
                const float eq0 = __builtin_amdgcn_exp2f(b0 - bref0), eq1 = __builtin_amdgcn_exp2f(b1 - bref1), ek0 = frcp(eq0), ek1 = frcp(eq1);
                const float k0 = 1.0f - __builtin_amdgcn_exp2f(bflo(rg[i])), k1 = 1.0f - __builtin_amdgcn_exp2f(bfhi(rg[i]));
                const float ks0 = k0 * ek0, ks1 = k1 * ek1;
                kb0[i] = ks0 * eer0; kb1[i] = ks1 * eer1;
                if (lat) {
                    const int sx = 8 * w + i;
                    *(LAS unsigned*)(L + GF_QS + sx * ST128 + 4 * lane) = cvt_pk_bf16(bflo(rq[i]) * eq0, bfhi(rq[i]) * eq1);
                    *(LAS unsigned*)(L + GF_KS + sx * ST128 + 4 * lane) = cvt_pk_bf16(ks0, ks1);
                }
            }
            { u32x4 o; o.x = cvt_pk_bf16(kb0[0], kb0[1]); o.y = cvt_pk_bf16(kb0[2], kb0[3]); o.z = cvt_pk_bf16(kb0[4], kb0[5]); o.w = cvt_pk_bf16(kb0[6], kb0[7]);
              *(LAS u32x4*)(L + GF_KBT + (2 * lane) * ST64 + 16 * w) = o;
              o.x = cvt_pk_bf16(kb1[0], kb1[1]); o.y = cvt_pk_bf16(kb1[2], kb1[3]); o.z = cvt_pk_bf16(kb1[4], kb1[5]); o.w = cvt_pk_bf16(kb1[6], kb1[7]);
              *(LAS u32x4*)(L + GF_KBT + (2 * lane + 1) * ST64 + 16 * w) = o;
              o.x = (rv[0] & 0xffffu) | (rv[1] << 16); o.y = (rv[2] & 0xffffu) | (rv[3] << 16); o.z = (rv[4] & 0xffffu) | (rv[5] << 16); o.w = (rv[6] & 0xffffu) | (rv[7] << 16);
              *(LAS u32x4*)(L + GF_VT + (2 * lane) * ST64 + 16 * w) = o;
              o.x = (rv[0] >> 16) | (rv[1] & 0xffff0000u); o.y = (rv[2] >> 16) | (rv[3] & 0xffff0000u); o.z = (rv[4] >> 16) | (rv[5] & 0xffff0000u); o.w = (rv[6] >> 16) | (rv[7] & 0xffff0000u);
              *(LAS u32x4*)(L + GF_VT + (2 * lane + 1) * ST64 + 16 * w) = o; }
            if (w == 0) *(LAS f32x2*)(L + GF_EE + 8 * lane) = (f32x2){__builtin_amdgcn_exp2f(bend0), __builtin_amdgcn_exp2f(bend1)};
            if (lat) {
                f32x4 br = (f32x4){0.f, 0.f, 0.f, 0.f};
#pragma unroll
                for (int k = 0; k < 4; ++k) br += *(const LAS f32x4*)(L + GF_TOT + ((dir ? k + 4 : k) * 128 + 16 * w + 4 * fq) * 4);
                const f32x4 er = (f32x4){__builtin_amdgcn_exp2f(br.x), __builtin_amdgcn_exp2f(br.y), __builtin_amdgcn_exp2f(br.z), __builtin_amdgcn_exp2f(br.w)};
#pragma unroll
                for (int vt = 0; vt < 8; ++vt) { const f32x4 sv = accS[vt] * er; u32x2 o; o.x = cvt_pk_bf16(sv[0], sv[1]); o.y = cvt_pk_bf16(sv[2], sv[3]);
                    *(LAS u32x2*)(L + GF_ST + (16 * vt + fr) * ST128 + 2 * (16 * w + 4 * fq)) = o; } }
            const int lc = dir ? 35 - st : st - 4;
            if (st + 1 < 36) GLF_LOAD(st + 1);
            LDSBAR();
            if (lat) {
#pragma unroll
                for (int x = 0; x < 2; ++x) {
                    const int id = 2 * w + x, sti = id >> 2, tti = id & 3;
                    f32x4 a = (f32x4){0.f, 0.f, 0.f, 0.f};
#pragma unroll
                    for (int ks = 0; ks < 4; ++ks) {
                        const bf16x8 fa = *(const LAS bf16x8*)(L + GF_KS + (16 * sti + fr) * ST128 + (32 * ks + 8 * fq) * 2);
                        const bf16x8 fb = *(const LAS bf16x8*)(L + GF_QS + (16 * tti + fr) * ST128 + (32 * ks + 8 * fq) * 2);
                        a = MFMA16(fa, fb, a); }
                    const int t = 16 * tti + fr, s0 = 16 * sti + 4 * fq;
                    float v[4];
#pragma unroll
                    for (int r = 0; r < 4; ++r) { const int sx = s0 + r; const bool keep = dir ? (sx >= t) : (sx <= t); v[r] = keep ? a[r] : 0.f; }
                    u32x2 o; o.x = cvt_pk_bf16(v[0], v[1]); o.y = cvt_pk_bf16(v[2], v[3]);
                    *(LAS u32x2*)(L + GF_P + t * ST64 + 2 * s0) = o;
                }
                LDSBAR();
                { const int vti = w;
                  bf16x8 fv[2], fs[4];
#pragma unroll
                  for (int ks = 0; ks < 2; ++ks) fv[ks] = *(const LAS bf16x8*)(L + GF_VT + (16 * vti + fr) * ST64 + (32 * ks + 8 * fq) * 2);
#pragma unroll
                  for (int ks = 0; ks < 4; ++ks) fs[ks] = *(const LAS bf16x8*)(L + GF_ST + (16 * vti + fr) * ST128 + (32 * ks + 8 * fq) * 2);
#pragma unroll
                  for (int x = 0; x < 4; ++x) {
                    const int tti = x;
                    f32x4 o = (f32x4){0.f, 0.f, 0.f, 0.f};
#pragma unroll
                    for (int ks = 0; ks < 2; ++ks) { const bf16x8 fb = *(const LAS bf16x8*)(L + GF_P + (16 * tti + fr) * ST64 + (32 * ks + 8 * fq) * 2); o = MFMA16(fv[ks], fb, o); }
#pragma unroll
                    for (int ks = 0; ks < 4; ++ks) { const bf16x8 fb = *(const LAS bf16x8*)(L + GF_QS + (16 * tti + fr) * ST128 + (32 * ks + 8 * fq) * 2); o = MFMA16(fs[ks], fb, o); }
                    const int t = 16 * tti + fr; const size_t row = (size_t)bl * T + lc * 64 + t;
                    u32x2 ov; ov.x = cvt_pk_bf16(o[0], o[1]); ov.y = cvt_pk_bf16(o[2], o[3]);
                    *(u32x2*)(O + row * D + h * 128 + 16 * vti + 4 * fq) = ov;
                  } }
            }
            { const f32x4 ee = *(const LAS f32x4*)(L + GF_EE + (16 * w + 4 * fq) * 4);
#pragma unroll
              for (int vt = 0; vt < 8; ++vt) accS[vt] *= ee;
#pragma unroll
              for (int ks = 0; ks < 2; ++ks) {
                  const bf16x8 fa = *(const LAS bf16x8*)(L + GF_KBT + (16 * w + fr) * ST64 + (32 * ks + 8 * fq) * 2);
#pragma unroll
                  for (int vt = 0; vt < 8; ++vt) { const bf16x8 fb = *(const LAS bf16x8*)(L + GF_VT + (16 * vt + fr) * ST64 + (32 * ks + 8 * fq) * 2); accS[vt] = MFMA16(fa, fb, accS[vt]); } } }
        }
#undef GLF_LOAD
        LDSBAR();
    }
}

__device__ __forceinline__ void p4_ya_cmlp(Frame& F, int grp) {
    const bf16* Z = WSP(bf16, WS_Z); const bf16* OFp = WSP(bf16, WS_OF); const bf16* OBp = WSP(bf16, WS_OB); bf16* YA = WSP(bf16, WS_YA); bf16* YB = WSP(bf16, WS_YB);
    const float* vstat = WSP(float, WS_VSTAT); const bf16* WSB = WSP(bf16, WS_WSB);
    LAS unsigned char* L = F.lds; CArgs* ap = argp(); const float* gng = INP(11); const float* bsp = INP(13);
    const int lane = F.lane, w = F.wave, fr = lane & 15, fq = lane >> 4, gw = F.blk * 8 + w, NGW = F.G * 8;
    { const int r0 = gw, r1 = TG, rstep = NGW;
      float gn[16];
      { const float* gp = gng + ((16 * lane) & 127);
#pragma unroll
        for (int i = 0; i < 16; i += 4) { const f32x4 t = *(const f32x4*)(gp + i); gn[i] = t.x; gn[i + 1] = t.y; gn[i + 2] = t.z; gn[i + 3] = t.w; } }
      for (int r = r0; r < r1; r += 2 * rstep) {
        const int rr[2] = {r, (r + rstep < r1) ? r + rstep : r};
        u32x4 la[2][2], lb[2][2], lg[2][2];
#pragma unroll
        for (int q = 0; q < 2; ++q)
#pragma unroll
            for (int hh = 0; hh < 2; ++hh) { la[q][hh] = ((const u32x4*)(OFp + (size_t)rr[q] * D) + 2 * lane)[hh]; lb[q][hh] = ((const u32x4*)(OBp + (size_t)rr[q] * D) + 2 * lane)[hh]; lg[q][hh] = ((const u32x4*)(Z + (size_t)rr[q] * INW + 4096) + 2 * lane)[hh]; }
#pragma unroll
        for (int q = 0; q < 2; ++q) {
            float o[16], gte[16]; float ss = 0.f;
#pragma unroll
            for (int hh = 0; hh < 2; ++hh)
#pragma unroll
                for (int j = 0; j < 4; ++j) { o[hh * 8 + 2 * j] = (MK_GLA_MODE == 1) ? 1.0f : bflo(la[q][hh][j]) + bflo(lb[q][hh][j]); o[hh * 8 + 2 * j + 1] = (MK_GLA_MODE == 1) ? 1.0f : bfhi(la[q][hh][j]) + bfhi(lb[q][hh][j]); { const float g0 = bflo(lg[q][hh][j]), g1 = bfhi(lg[q][hh][j]); gte[hh * 8 + 2 * j] = g0 * fsigmoid(g0); gte[hh * 8 + 2 * j + 1] = g1 * fsigmoid(g1); } }
#pragma unroll
            for (int i = 0; i < 16; ++i) ss += o[i] * o[i];
            ss += SWZ_XOR(ss, 1); ss += SWZ_XOR(ss, 2); ss += SWZ_XOR(ss, 4);
            const float rstd = frsq(ss * (1.0f / 128.0f) + EPS);
            u32x4 ov[2];
#pragma unroll
            for (int hh = 0; hh < 2; ++hh)
#pragma unroll
                for (int j = 0; j < 4; ++j) { const int i0 = hh * 8 + 2 * j; ov[hh][j] = cvt_pk_bf16(o[i0] * rstd * gn[i0] * gte[i0], o[i0 + 1] * rstd * gn[i0 + 1] * gte[i0 + 1]); }
            if (MK_P5_FP8) { float yv[16];
#pragma unroll
                for (int i = 0; i < 16; ++i) yv[i] = o[i] * rstd * gn[i] * gte[i];
                u32x4 o8; o8.x = pack4_fp8(yv[0], yv[1], yv[2], yv[3]); o8.y = pack4_fp8(yv[4], yv[5], yv[6], yv[7]); o8.z = pack4_fp8(yv[8], yv[9], yv[10], yv[11]); o8.w = pack4_fp8(yv[12], yv[13], yv[14], yv[15]);
                *((u32x4*)((unsigned char*)YA + (size_t)rr[q] * D) + lane) = o8; }
            else { u32x4* po = (u32x4*)(YA + (size_t)rr[q] * D) + 2 * lane; po[0] = ov[0]; po[1] = ov[1]; }
        }
      } }
    LAS f32x2* STAT = (LAS f32x2*)L; constexpr int VNT = 1024, WSL = 1024 + 128 * ST128;
    const int NIT = GB * 16 * 8;
    u32x2 rawv[8]; f32x2 rst[16]; int g_loaded = -1;
    const int c4 = F.tid & 31, sb = F.tid >> 5;
#define P4_PREFETCH(it_) do { const int g_ = (it_) & 7, n_ = ((it_) >> 3) & 15, bl_ = (it_) >> 7, tok_ = bl_ * T + n_ * 128; \
        { const bf16* zp = Z + (size_t)(tok_ + 8 * sb) * INW + 6144 + g_ * 128 + 4 * c4; \
          _Pragma("unroll") for (int i2 = 0; i2 < 8; ++i2) rawv[i2] = *(const u32x2*)(zp + (size_t)i2 * INW); } \
        if (F.tid < 128) { const f32x2* vs = (const f32x2*)vstat + (size_t)(tok_ + F.tid) * 16; _Pragma("unroll") for (int j = 0; j < 16; ++j) rst[j] = vs[j]; } } while (0)
    if (F.blk < NIT) P4_PREFETCH(F.blk);
    for (int it = F.blk; it < NIT; it += F.G) {
        const int g = it & 7, n = (it >> 3) & 15, bl = it >> 7, tok0 = bl * T + n * 128;
        if (g != g_loaded) {
            for (int idx = F.tid; idx < 128 * 16; idx += 512) { const int t = idx >> 4, ch = idx & 15; *(LAS u32x4*)(L + WSL + t * ST128 + ch * 16) = *(const u32x4*)(WSB + (size_t)g * 16384 + t * 128 + ch * 8); }
            g_loaded = g; }
        if (F.tid < 128) { float s1 = 0.f, s2 = 0.f;
#pragma unroll
            for (int j = 0; j < 16; ++j) { s1 += rst[j].x; s2 += rst[j].y; }
            const float mu = s1 * (1.0f / D); float var = s2 * (1.0f / D) - mu * mu; var = var > 0.f ? var : 0.f;
            STAT[F.tid] = (f32x2){mu, frsq(var + EPS)}; }
        LDSBAR();
        { f32x2 sv[8];
#pragma unroll
          for (int i2 = 0; i2 < 8; ++i2) sv[i2] = STAT[8 * sb + i2];
#pragma unroll
          for (int j = 0; j < 4; ++j) { float xv[8];
#pragma unroll
              for (int i2 = 0; i2 < 8; ++i2) { const unsigned wv = (j < 2) ? rawv[i2].x : rawv[i2].y; xv[i2] = (((j & 1) ? bfhi(wv) : bflo(wv)) - sv[i2].x) * sv[i2].y; }
              u32x4 o; o.x = cvt_pk_bf16(xv[0], xv[1]); o.y = cvt_pk_bf16(xv[2], xv[3]); o.z = cvt_pk_bf16(xv[4], xv[5]); o.w = cvt_pk_bf16(xv[6], xv[7]);
              const int row = 4 * c4 + j;
              *(LAS u32x4*)(L + VNT + row * ST128 + ((sb ^ ((row >> 3) & 7)) * 16)) = o; } }
        const int wq = w & 3, th = w >> 2;
        u32x4 uu[4]; float bsv[4];
#pragma unroll
        for (int tq = 0; tq < 4; ++tq) { const int t = 16 * (4 * th + tq) + fr; uu[tq] = *(const u32x4*)(Z + (size_t)(tok0 + t) * INW + 5120 + g * 128 + 32 * wq + 8 * fq); bsv[tq] = bsp[g * 128 + t]; }
        if (it + F.G < NIT) P4_PREFETCH(it + F.G);
        LDSBAR();
        f32x4 acc[2][4];
#pragma unroll
        for (int ct = 0; ct < 2; ++ct)
#pragma unroll
            for (int tq = 0; tq < 4; ++tq) acc[ct][tq] = (f32x4){0.f, 0.f, 0.f, 0.f};
        { const int swz = (4 * wq + (fr >> 2)) & 7;
          const int arow = (32 * wq + 8 * (fr >> 2) + (fr & 3)) * ST128;
          bf16x8 fa[2][2], fb[2][4];
#define P4_FRAGS(ks_, buf_) do { _Pragma("unroll") for (int ct = 0; ct < 2; ++ct) fa[buf_][ct] = *(const LAS bf16x8*)(L + VNT + arow + 4 * ct * ST128 + (((4 * (ks_) + fq) ^ swz) * 16)); \
            _Pragma("unroll") for (int tq = 0; tq < 4; ++tq) fb[buf_][tq] = *(const LAS bf16x8*)(L + WSL + (16 * (4 * th + tq) + fr) * ST128 + (32 * (ks_) + 8 * fq) * 2); } while (0)
          P4_FRAGS(0, 0);
#pragma unroll
          for (int ks = 0; ks < 4; ++ks) {
              if (ks < 3) P4_FRAGS(ks + 1, (ks + 1) & 1);
              __builtin_amdgcn_sched_barrier(0);
#pragma unroll
              for (int ct = 0; ct < 2; ++ct)
#pragma unroll
                  for (int tq = 0; tq < 4; ++tq) acc[ct][tq] = MFMA16(fa[ks & 1][ct], fb[ks & 1][tq], acc[ct][tq]);
              __builtin_amdgcn_sched_barrier(0); }
#undef P4_FRAGS
        }
#pragma unroll
        for (int tq = 0; tq < 4; ++tq) { const int t = 16 * (4 * th + tq) + fr, cc = g * 128 + 32 * wq + 8 * fq; const size_t row = (size_t)tok0 + t; const float bs = bsv[tq]; const u32x4 u4 = uu[tq];
            float y[8];
            y[0] = bflo(u4.x) * (acc[0][tq][0] + bs); y[1] = bfhi(u4.x) * (acc[0][tq][1] + bs); y[2] = bflo(u4.y) * (acc[0][tq][2] + bs); y[3] = bfhi(u4.y) * (acc[0][tq][3] + bs);
            y[4] = bflo(u4.z) * (acc[1][tq][0] + bs); y[5] = bfhi(u4.z) * (acc[1][tq][1] + bs); y[6] = bflo(u4.w) * (acc[1][tq][2] + bs); y[7] = bfhi(u4.w) * (acc[1][tq][3] + bs);
            if (MK_P5_FP8) { u32x2 o; o.x = pack4_fp8(y[0], y[1], y[2], y[3]); o.y = pack4_fp8(y[4], y[5], y[6], y[7]); *(u32x2*)((unsigned char*)YB + row * D + cc) = o; }
            else { u32x4 o; o.x = cvt_pk_bf16(y[0], y[1]); o.y = cvt_pk_bf16(y[2], y[3]); o.z = cvt_pk_bf16(y[4], y[5]); o.w = cvt_pk_bf16(y[6], y[7]); *(u32x4*)(YB + row * D + cc) = o; } }
        LDSBAR();
    }
#undef P4_PREFETCH
}

constexpr int P7_HI = 0, P7_LO = 65536, P7_LOG = 131072, P7_ENT = 131072 + 8704;
__device__ __forceinline__ void p7_router(Frame& F, int grp, const bool dry) {
    const float* mod = WSP(float, WS_MOD); const bf16* whi = WSP(bf16, WS_WRT); const bf16* wlo = whi + 32 * 1024; unsigned char* H2 = WSP(unsigned char, WS_H2); unsigned* list = WSP(unsigned, WS_LIST); float* topw = WSP(float, WS_TOPW); unsigned* spos = WSP(unsigned, WS_SPOS);
    LAS unsigned char* L = F.lds; LAS float* LOG = (LAS float*)(L + P7_LOG); LAS unsigned* LENT = (LAS unsigned*)(L + P7_ENT);
    const int lane = F.lane, w = F.wave, fr = lane & 15, fq = lane >> 4; CArgs* ap = argp(); const float* n2g = INP(5); const float* brt = INP(18); const float* xin = INP(0); (void)xin;
    const bf16* x1b = X1P(0);
    for (int chunk = F.blk; chunk < TGM / 64; chunk += F.G) {
        if (F.tid < 32) F.LC[LC_LCNT + F.tid] = 0u;
        f32x4 ma[4], mb[4];
        { const float* mrow = mod + (((size_t)grp * TG + chunk * 64) >> 11) * 6144;
          f32x4 t0[4], t1[4];
#pragma unroll
          for (int j = 0; j < 4; ++j) { t0[j] = ((const f32x4*)n2g)[lane + 64 * j]; t1[j] = ((const f32x4*)(mrow + 4096))[lane + 64 * j]; mb[j] = ((const f32x4*)(mrow + 3072))[lane + 64 * j]; }
#pragma unroll
          for (int j = 0; j < 4; ++j) ma[j] = t0[j] * (t1[j] + 1.0f); }
        for (int pass = 0; pass < 2; ++pass) {
            { u32x2 xw[4][4];
#pragma unroll
              for (int rr = 0; rr < 4; ++rr) { const int rowl = chunk * 64 + pass * 32 + w * 4 + rr;
#pragma unroll
                  for (int j = 0; j < 4; ++j) xw[rr][j] = ((const u32x2*)(x1b + (size_t)rowl * X1S))[lane + 64 * j]; }
              asm volatile("" ::: "memory");
#pragma unroll
              for (int rr = 0; rr < 4; ++rr) {
                const int lr = w * 4 + rr, rowl = chunk * 64 + pass * 32 + lr;
                f32x4 v[4]; float s = 0.f;
#pragma unroll
                for (int j = 0; j < 4; ++j) { v[j] = (f32x4){bflo(xw[rr][j].x), bfhi(xw[rr][j].x), bflo(xw[rr][j].y), bfhi(xw[rr][j].y)}; s += (v[j].x * v[j].x + v[j].y * v[j].y) + (v[j].z * v[j].z + v[j].w * v[j].w); }
                const float rstd = frsq(wave_sum(s) * (1.0f / D) + EPS);
#pragma unroll
                for (int j = 0; j < 4; ++j) {
                    const f32x4 h = v[j] * rstd * ma[j] + mb[j];
                    u32x2 hi; hi.x = cvt_pk_bf16(h.x, h.y); hi.y = cvt_pk_bf16(h.z, h.w);
                    u32x2 lo; lo.x = cvt_pk_bf16(h.x - bflo(hi.x), h.y - bfhi(hi.x)); lo.y = cvt_pk_bf16(h.z - bflo(hi.y), h.w - bfhi(hi.y));
                    ((unsigned*)(H2 + (size_t)rowl * D))[lane + 64 * j] = pack4_fp8(h.x, h.y, h.z, h.w);
                    const int ch = ((lane >> 1) + 32 * j) ^ (lr & 15), off = lr * 2048 + ch * 16 + 8 * (lane & 1);
                    *(LAS u32x2*)(L + P7_HI + off) = hi; *(LAS u32x2*)(L + P7_LO + off) = lo; }
              } }
            bf16x8 bwh[16], bwl[16];
            { const int et = (w >> 1) & 1, kh = w & 1; const bf16* bh = whi + (size_t)(16 * et + fr) * 1024 + 8 * fq + 512 * kh; const bf16* bl = wlo + (size_t)(16 * et + fr) * 1024 + 8 * fq + 512 * kh;
#pragma unroll
              for (int k = 0; k < 16; ++k) { bwh[k] = *(const bf16x8*)(bh + 32 * k); bwl[k] = *(const bf16x8*)(bl + 32 * k); } }
            LDSBAR();
            { const int rt = w >> 2, et = (w >> 1) & 1, kh = w & 1, lr = 16 * rt + fr;
              f32x4 a0 = (f32x4){0.f, 0.f, 0.f, 0.f}, a1 = a0, a2 = a0;
              bf16x8 ahi[2], alo[2];
              { const int off = lr * 2048 + (((4 * (16 * kh) + fq) ^ (lr & 15)) * 16); ahi[0] = *(const LAS bf16x8*)(L + P7_HI + off); alo[0] = *(const LAS bf16x8*)(L + P7_LO + off); }
#pragma unroll
              for (int k = 0; k < 16; ++k) {
                  if (k < 15) { const int ks = 16 * kh + k + 1; const int off = lr * 2048 + (((4 * ks + fq) ^ (lr & 15)) * 16);
                      ahi[(k + 1) & 1] = *(const LAS bf16x8*)(L + P7_HI + off); alo[(k + 1) & 1] = *(const LAS bf16x8*)(L + P7_LO + off); }
                  __builtin_amdgcn_sched_barrier(0);
                  a0 = MFMA16(ahi[k & 1], bwh[k], a0); a1 = MFMA16(alo[k & 1], bwh[k], a1); a2 = MFMA16(ahi[k & 1], bwl[k], a2);
                  __builtin_amdgcn_sched_barrier(0); }
              const f32x4 acc = a0 + (a1 + a2);
              const float bias = kh ? 0.f : brt[16 * et + fr];
#pragma unroll
              for (int r = 0; r < 4; ++r) LOG[(kh * 32 + 16 * rt + 4 * fq + r) * 33 + 16 * et + fr] = acc[r] + bias; }
            LDSBAR();
            if (F.tid < 32) {
                const int lr = F.tid, rowl = chunk * 64 + pass * 32 + lr;
                float p[32];
#pragma unroll
                for (int e = 0; e < 32; ++e) p[e] = LOG[lr * 33 + e] + LOG[(32 + lr) * 33 + e];
#pragma unroll
                for (int e = 0; e < 32; ++e) { const unsigned ex = (unsigned)e; const unsigned b = __float_as_uint(p[e]); p[e] = __uint_as_float((b & ~31u) | ((b >> 31) ? ex : 31u - ex)); }
                float m0 = 0.f, sumexp = 0.f;
                LAS float* LTW = (LAS float*)(L + P7_ENT + 1024);
#pragma unroll
                for (int k = 0; k < 4; ++k) {
                    float m = p[0];
#pragma unroll
                    for (int e = 1; e < 32; ++e) m = __builtin_fmaxf(m, p[e]);
                    const unsigned mb = __float_as_uint(m); const int mi = (int)((mb >> 31) ? (mb & 31u) : 31u - (mb & 31u));
#pragma unroll
                    for (int e = 0; e < 32; ++e) p[e] = (p[e] == m) ? -3.0e38f : p[e];
                    if (k == 0) m0 = m;
                    const float ex_ = fexp(m - m0); sumexp += ex_;
                    const unsigned pos = __hip_atomic_fetch_add((LAS unsigned*)&F.LC[LC_LCNT + mi], 1u, __ATOMIC_RELAXED, __HIP_MEMORY_SCOPE_WORKGROUP);
                    LENT[(pass * 32 + lr) * 4 + k] = ((unsigned)mi << 16) | pos; LTW[lr * 4 + k] = ex_; }
                const float inv = frcp(sumexp); const f32x4 tw = *(const LAS f32x4*)(LTW + lr * 4);
                *(f32x4*)(topw + (size_t)rowl * 4) = tw * inv;
            }
            LDSBAR();
        }
        { const int t_ = launder(F.tid); if (t_ < 32 && !dry) F.LC[LC_LBASE + t_] = __hip_atomic_fetch_add(F.ctl + CW_CNT + (grp * 32 + t_) * 64, F.LC[LC_LCNT + t_], __ATOMIC_RELAXED, __HIP_MEMORY_SCOPE_AGENT); }
        LDSBAR();
        if (F.tid < 256 && !dry) { const unsigned en = LENT[F.tid], e = en >> 16, pos = F.LC[LC_LBASE + e] + (en & 0xffffu); const unsigned slot = (unsigned)(chunk * 64 + (F.tid >> 2)) * 4u + (F.tid & 3u); list[(size_t)e * TGM + pos] = slot; spos[slot] = (e << 16) | pos; }
        LDSBAR();
    }
}

__global__ void __launch_bounds__(512, 2) fwd(Args args) {
    extern __shared__ __attribute__((aligned(16))) unsigned char lds[];
    Frame F;
    F.lds = (LAS unsigned char*)lds; F.LC = (volatile LAS unsigned*)(F.lds + LDSCTL_OFF);
    F.tid = threadIdx.x; F.lane = F.tid & 63; F.wave = __builtin_amdgcn_readfirstlane(F.tid >> 6); F.G = gridDim.x; F.blk = blockIdx.x;
    F.ws = (GAS unsigned char*)args.ws; F.ctl = (gu32*)(args.ws + WS_CTL); F.out = (GAS float*)args.out;
    for (int u = F.tid; u < 256; u += 512) F.LC[u] = 0u;
    __syncthreads();
#if !MK_PER_PHASE
    XcdBarrier bar = xcd_barrier_post((unsigned*)(F.ctl + CW_BAR), F.LC + LC_BAR, F.wave);
#define GRID_BAR() xcd_barrier(bar)
#else
#define GRID_BAR() do {} while (0)
#endif
    const int lo = args.pid_lo, hi = args.pid_hi;
#ifndef MK_MASK
#define MK_MASK 0xFFFF
#endif
#define IN(k) (lo <= (k) && (k) < hi)
#define PHON(p) ((MK_MASK >> (p)) & 1)
#define SEAM(k) do { if (IN((k) + 1)) GRID_BAR(); } while (0)
#define MKRSRC() __builtin_amdgcn_make_buffer_rsrc((void*)F.ws, 0, 0x7fffffff, 0x00020000)
#define REFRESH() do { F.lane = lane_now(); F.tid = F.wave * 64 + F.lane; \
        { GAS unsigned char* w_ = F.ws; asm volatile("" : "+s"(w_)); F.ws = w_; GAS float* o_ = F.out; asm volatile("" : "+s"(o_)); F.out = o_; } } while (0)
    LAS unsigned char* ring = F.lds;
    if (PHON(0) && IN(0)) { REFRESH(); p0_prologue(F); SEAM(0); }
    for (int grp = 0; grp < NG; ++grp) {
        const int pb = 1 + grp * NPH;
#if !MK_SKIP_MIXER
        if (PHON(1) && IN(pb + 0)) { if (grp == 0 || MK_PER_PHASE || MK_TIME_PHASE >= 0) { REFRESH(); p1_rows(F, grp); SEAM(pb + 0); } }
        if (PHON(2) && IN(pb + 1)) {
            REFRESH();
            SchedProj<16> S{F.G, F.blk, (TG / 256) * 16, grp == 0 ? (NCTX / 256) * 12 : 0, (unsigned)WS_H, (unsigned)WS_HC, (unsigned)WS_WIN, 0};
            EpiProj E{WSP(bf16, WS_Z), WSP(bf16, WS_ZC), WSP(float, WS_LB), WSP(float, WS_VSTAT)};
            pg8::gemm_phase<EpiProj, SchedProj<16>, false, MK_P2_FP8 != 0>(ring, MKRSRC(), F.tid, D, S, E);
            SEAM(pb + 1);
        }
        if (PHON(3) && IN(pb + 2)) {
            REFRESH();
            p3_gla_full(F, grp);
            REFRESH();
            { SchedProj<20> S{F.G, F.blk, (TG / 256) * 20, 0, (unsigned)WS_H, (unsigned)WS_HC, (unsigned)WS_WIN, 16};
              EpiProj E{WSP(bf16, WS_Z), WSP(bf16, WS_ZC), WSP(float, WS_LB), WSP(float, WS_VSTAT)};
              pg8::gemm_phase<EpiProj, SchedProj<20>, false, MK_P2_FP8 != 0>(ring, MKRSRC(), F.tid, D, S, E); }
            SEAM(pb + 2);
        }
        if (PHON(4) && IN(pb + 3)) { for (int rep_ = 0; rep_ < REPS(4); ++rep_) { REFRESH(); p4_ya_cmlp(F, grp); } SEAM(pb + 3); }
        if (PHON(5) && IN(pb + 4)) {
            REFRESH();
            SchedBranch S{F.G, F.blk, (unsigned)WS_YA, (unsigned)WS_YB, (unsigned)WS_WBA, (unsigned)WS_WBB};
            EpiBranch E{WSP(bf16, WS_Z), WSP(bf16, WS_OF), WSP(bf16, WS_MERGED)};
            for (int rep_ = 0; rep_ < REPS(5); ++rep_) pg8::gemm_phase<EpiBranch, SchedBranch, false, MK_P5_FP8 != 0, false>(ring, MKRSRC(), F.tid, D, S, E);
            SEAM(pb + 4);
        }
        if (PHON(6) && IN(pb + 5)) {
            REFRESH();
            SchedOut S{F.G, F.blk, (unsigned)WS_MERGED, (unsigned)WS_WOUT};
            EpiOut E{argp()->in[0], X1P((size_t)grp * TG), WSP(float, WS_MOD), grp};
            for (int rep_ = 0; rep_ < REPS(6); ++rep_) pg8::gemm_phase<EpiOut, SchedOut, false, MK_P6_FP8 != 0, false>(ring, MKRSRC(), F.tid, D, S, E);
            if (!MK_PER_PHASE && MK_TIME_PHASE < 0 && grp + 1 < NG) { REFRESH(); p1_rows(F, grp + 1); }
            SEAM(pb + 5);
        }
#else
        if (IN(pb + 0)) SEAM(pb + 0);
        if (IN(pb + 1)) SEAM(pb + 1);
        if (IN(pb + 2)) SEAM(pb + 2);
        if (IN(pb + 3)) SEAM(pb + 3);
        if (IN(pb + 4)) SEAM(pb + 4);
        if (IN(pb + 5)) SEAM(pb + 5);
#endif
    }
    {
        constexpr int grp = 0; const int pb = 1 + NG * NPH - 6;
#if !MK_SKIP_MOE
        if (PHON(7) && IN(pb + 6)) { REFRESH(); p7_router(F, grp, args.dry != 0); SEAM(pb + 6); }
        if (PHON(8) && IN(pb + 7)) {
            REFRESH(); moe_tables(F, grp);
            SchedMoe S{F.G, F.blk, 3, F.LC, (unsigned)WS_H2, (unsigned)WS_W1, WSP(unsigned, WS_LIST), false};
            EpiMoe1 E{WSP(unsigned char, WS_ACT), argp()->in[20]};
            for (int rep_ = 0; rep_ < REPS(8); ++rep_) pg8::gemm_phase<EpiMoe1, SchedMoe, true, true>(ring, MKRSRC(), F.tid, D, S, E);
            SEAM(pb + 7);
        }
        if (PHON(9) && IN(pb + 8)) {
            REFRESH(); moe_tables(F, grp);
            SchedMoe S{F.G, F.blk, 2, F.LC, (unsigned)WS_ACT, (unsigned)WS_W2, WSP(unsigned, WS_LIST), true};
            EpiMoe2 E{WSP(bf16, WS_YSLOT), argp()->in[22]};
            for (int rep_ = 0; rep_ < REPS(9); ++rep_) pg8::gemm_phase<EpiMoe2, SchedMoe, false, true, true>(ring, MKRSRC(), F.tid, FE, S, E);
            SEAM(pb + 8);
        }
#else
        if (IN(pb + 6)) SEAM(pb + 6);
        if (IN(pb + 7)) SEAM(pb + 7);
        if (IN(pb + 8)) SEAM(pb + 8);
#endif
        if (PHON(10) && IN(pb + 9)) { REFRESH(); if (MK_PER_PHASE || MK_TIME_PHASE >= 0) moe_tables(F, grp); p10_final(F, grp); SEAM(pb + 9); }
    }
}

extern "C" void kernel_launch(void* const* d_in, const int* in_sizes, int n_in, void* d_out, int out_size, void* d_ws, size_t ws_size, hipStream_t stream) {
    static int grid = 0;
    if (grid == 0) {
        if (n_in != 24 || out_size != NTOK * D || ws_size < WS_END) { fprintf(stderr, "kernel_launch: unexpected shapes (n_in %d out %d ws %zu)\n", n_in, out_size, ws_size); grid = -1; return; }
        int dev = 0, cus = 0, per_cu = 0;
        if (hipGetDevice(&dev) != hipSuccess || hipDeviceGetAttribute(&cus, hipDeviceAttributeMultiprocessorCount, dev) != hipSuccess) { grid = -1; return; }
        if (hipFuncSetAttribute((const void*)fwd, hipFuncAttributeMaxDynamicSharedMemorySize, LDS_BYTES) != hipSuccess) { fprintf(stderr, "kernel_launch: hipFuncSetAttribute failed\n"); grid = -1; return; }
        if (hipOccupancyMaxActiveBlocksPerMultiprocessor(&per_cu, (const void*)fwd, 512, LDS_BYTES) != hipSuccess || per_cu < 1) fprintf(stderr, "kernel_launch: occupancy query reports %d\n", per_cu);
        (void)hipGetLastError();
        grid = cus;
    }
    if (grid < 0) return;
    if (hipMemsetAsync((char*)d_ws + WS_CTL, 0, CTL_ZERO_BYTES, stream) != hipSuccess) return;
    Args a{}; a.dry = 0; a.pad = 0;
    for (int i = 0; i < 24; ++i) a.in[i] = (const float*)d_in[i];
    a.out = (float*)d_out; a.ws = (unsigned char*)d_ws;
#if MK_PER_PHASE
    for (int pid = 0; pid < NPID; ++pid) { a.pid_lo = pid; a.pid_hi = pid + 1; hipLaunchKernelGGL(fwd, dim3(grid), dim3(512), LDS_BYTES, stream, a); }
#else
    a.pid_lo = 0; a.pid_hi = NPID; hipLaunchKernelGGL(fwd, dim3(grid), dim3(512), LDS_BYTES, stream, a);
#if MK_TIME_PHASE >= 0
    for (int g = 0; g < (MK_TIME_PHASE == 0 ? 1 : NG); ++g) { a.pid_lo = MK_TIME_PHASE == 0 ? 0 : 1 + g * NPH + (MK_TIME_PHASE - 1); a.pid_hi = a.pid_lo + 1; a.dry = 1; hipLaunchKernelGGL(fwd, dim3(grid), dim3(512), LDS_BYTES, stream, a); }
#endif
#endif
    const hipError_t le = hipPeekAtLastError();
    if (le != hipSuccess) fprintf(stderr, "kernel_launch: launch failed: %s\n", hipGetErrorName(le));
}
```
